# Optimizing an MI355X kernel written in HIP

```python
import math
import jax, jax.numpy as jnp
from jax import lax
import numpy as np

D_MODEL = 1024
BATCH = 8
SEQ = 4096
DEPTH = 2

MIX_WIDTH = D_MODEL
A_WIDTH = MIX_WIDTH // 2
A_GROUPS = 4
A_GROUP_DIM = A_WIDTH // A_GROUPS
CHUNK = 128
B_WIDTH = MIX_WIDTH - A_WIDTH
HEAD_DIM = 64
B_HEADS = B_WIDTH // HEAD_DIM
ROT_DIM = HEAD_DIM // 4
ROPE_THETA = 500000.0
DILATED_PATTERNS = ((128, 1), (512, 4), (2048, 16))
IN_COLS = 2 * A_WIDTH + 3 * B_WIDTH
D_FF = 4 * D_MODEL
CONV_WIDTH = 3
EPS = 1e-6
NEG_INF = -1e30

kernel_name = 'hybrid_gmlp_dilated_attn_convffn'


def rmsnorm(x, g):
    xf = x.astype(jnp.float32)
    y = xf * lax.rsqrt(jnp.mean(xf * xf, axis=-1, keepdims=True) + EPS)
    return (y * g.astype(jnp.float32)).astype(x.dtype)


def layernorm(x, g, b):
    xf = x.astype(jnp.float32)
    mu = jnp.mean(xf, axis=-1, keepdims=True)
    xc = xf - mu
    y = xc * lax.rsqrt(jnp.mean(xc * xc, axis=-1, keepdims=True) + EPS)
    return (y * g.astype(jnp.float32) + b.astype(jnp.float32)).astype(x.dtype)


def partial_rope(x):
    s = x.shape[1]
    half = ROT_DIM // 2
    inv = ROPE_THETA ** (-jnp.arange(0, ROT_DIM, 2, dtype=jnp.float32) / ROT_DIM)
    ang = jnp.arange(s, dtype=jnp.float32)[:, None] * inv[None, :]
    cos = jnp.cos(ang)[None, :, None, :]
    sin = jnp.sin(ang)[None, :, None, :]
    xf = x.astype(jnp.float32)
    x1, x2 = xf[..., :half], xf[..., half:ROT_DIM]
    out = jnp.concatenate([x1 * cos - x2 * sin, x2 * cos + x1 * sin, xf[..., ROT_DIM:]], axis=-1)
    return out.astype(x.dtype)


def dilated_branch(q, k, v, window, dilation):
    bsz, s, h, dh = q.shape
    band = window // dilation
    n = s // dilation
    nb = -(-n // band)
    pad = nb * band - n

    def to_blocks(t):
        t = t.reshape(bsz, n, dilation, h, dh).transpose(0, 2, 1, 3, 4)
        t = jnp.pad(t, ((0, 0), (0, 0), (0, pad), (0, 0), (0, 0)))
        return t.reshape(bsz, dilation, nb, band, h, dh)

    def with_prev(t):
        prev = jnp.pad(t[:, :, :-1], ((0, 0), (0, 0), (1, 0), (0, 0), (0, 0), (0, 0)))
        return jnp.concatenate([prev, t], axis=3)

    qb = to_blocks(q)
    kc = with_prev(to_blocks(k))
    vc = with_prev(to_blocks(v))
    scores = jnp.einsum('brnqhd,brnkhd->brnhqk', qb, kc).astype(jnp.float32) * (dh ** -0.5)
    qi = jnp.arange(band)[:, None]
    kj = jnp.arange(2 * band)[None, :]
    dist = qi + band - kj
    blk = jnp.arange(nb)[:, None, None]
    valid = (dist >= 0) & (dist <= band) & (blk * band + kj - band >= 0)
    scores = jnp.where(valid[None, None, :, None], scores, NEG_INF)
    m = jnp.max(scores, axis=-1, keepdims=True)
    p = jnp.exp(scores - m)
    l = jnp.sum(p, axis=-1, keepdims=True)
    o = jnp.einsum('brnhqk,brnkhd->brnqhd', p.astype(v.dtype), vc).astype(jnp.float32)
    l_t = l[..., 0].transpose(0, 1, 2, 4, 3)
    lse = (m[..., 0] + jnp.log(l[..., 0])).transpose(0, 1, 2, 4, 3)
    o = o / l_t[..., None]
    o = o.reshape(bsz, dilation, nb * band, h, dh)[:, :, :n]
    o = o.transpose(0, 2, 1, 3, 4).reshape(bsz, s, h, dh)
    lse = lse.reshape(bsz, dilation, nb * band, h)[:, :, :n]
    lse = lse.transpose(0, 2, 1, 3).reshape(bsz, s, h)
    return o, lse


def mixer_spatial_gating(za, v_norm_g, v_norm_b, w_spatial, b_spatial):
    bsz, s, _ = za.shape
    za = jax.nn.gelu(za, approximate=False)
    u, va = za[..., :A_WIDTH], za[..., A_WIDTH:]
    va = layernorm(va, v_norm_g, v_norm_b)
    vch = va.reshape(bsz, s // CHUNK, CHUNK, A_GROUPS, A_GROUP_DIM)
    ws = w_spatial * jnp.tril(jnp.ones((CHUNK, CHUNK), dtype=w_spatial.dtype))
    sg = jnp.einsum('gpq,bnqgc->bnpgc', ws, vch) + b_spatial.T[None, None, :, :, None]
    return u * sg.reshape(bsz, s, A_WIDTH)


def mixer_dilated_attention(zb):
    bsz, s, _ = zb.shape
    qkv = zb.reshape(bsz, s, 3, B_HEADS, HEAD_DIM)
    q = partial_rope(qkv[:, :, 0])
    k = partial_rope(qkv[:, :, 1])
    v = qkv[:, :, 2]
    outs, lses = zip(*[dilated_branch(q, k, v, w, d) for (w, d) in DILATED_PATTERNS])
    alpha = jax.nn.softmax(jnp.stack(lses, axis=0), axis=0)
    o = jnp.sum(alpha[..., None] * jnp.stack(outs, axis=0), axis=0)
    return o.reshape(bsz, s, B_WIDTH).astype(zb.dtype)


def conv_ffn(h, w_up, conv_w, conv_b, w_down):
    s = h.shape[1]
    up = jnp.einsum('bsd,df->bsf', h, w_up)
    up_pad = jnp.pad(up, ((0, 0), (CONV_WIDTH - 1, 0), (0, 0)))
    conv = conv_b + sum(conv_w[i] * up_pad[:, i:i + s] for i in range(CONV_WIDTH))
    gate, val = conv[..., :D_FF], conv[..., D_FF:]
    y = jax.nn.gelu(gate, approximate=True) * val
    return jnp.einsum('bsf,fd->bsd', y, w_down)


def setup_inputs(seed: int = 0) -> dict:
    key = jax.random.key(seed)
    ks = jax.random.split(key, 18)
    f32 = jnp.float32

    def nrm(k, shape, scale):
        return jax.random.normal(k, shape, f32) * scale

    def gain(k, shape):
        return 1.0 + 0.05 * jax.random.normal(k, shape, f32)

    L = DEPTH
    return {
        'x': jax.random.normal(ks[0], (BATCH, SEQ, D_MODEL), f32),
        'pre_mix_norm': gain(ks[1], (L, D_MODEL)),
        'w_in': nrm(ks[2], (L, D_MODEL, IN_COLS), D_MODEL ** -0.5),
        'v_norm_g': gain(ks[3], (L, A_WIDTH)),
        'v_norm_b': nrm(ks[4], (L, A_WIDTH), 0.02),
        'w_spatial': nrm(ks[5], (L, A_GROUPS, CHUNK, CHUNK), CHUNK ** -0.5),
        'b_spatial': gain(ks[6], (L, A_GROUPS, CHUNK)),
        'out_norm_a': gain(ks[7], (L, A_WIDTH)),
        'out_norm_b': gain(ks[8], (L, B_WIDTH)),
        'w_out': nrm(ks[9], (L, MIX_WIDTH, D_MODEL), MIX_WIDTH ** -0.5),
        'post_mix_norm': gain(ks[10], (L, D_MODEL)),
        'pre_ffn_norm': gain(ks[11], (L, D_MODEL)),
        'w_up': nrm(ks[12], (L, D_MODEL, 2 * D_FF), D_MODEL ** -0.5),
        'conv_w': nrm(ks[13], (L, CONV_WIDTH, 2 * D_FF), CONV_WIDTH ** -0.5),
        'conv_b': nrm(ks[14], (L, 2 * D_FF), 0.02),
        'w_down': nrm(ks[15], (L, D_FF, D_MODEL), D_FF ** -0.5),
        'post_ffn_norm': gain(ks[16], (L, D_MODEL)),
    }


def reference(x, pre_mix_norm, w_in, v_norm_g, v_norm_b, w_spatial, b_spatial,
              out_norm_a, out_norm_b, w_out, post_mix_norm, pre_ffn_norm,
              w_up, conv_w, conv_b, w_down, post_ffn_norm):
    for l in range(DEPTH):
        h = rmsnorm(x, pre_mix_norm[l])
        proj = jnp.einsum('bsd,de->bse', h, w_in[l])
        o_a = mixer_spatial_gating(proj[..., :2 * A_WIDTH], v_norm_g[l], v_norm_b[l],
                                   w_spatial[l], b_spatial[l])
        o_b = mixer_dilated_attention(proj[..., 2 * A_WIDTH:])
        mixed = jnp.concatenate([rmsnorm(o_a, out_norm_a[l]), rmsnorm(o_b, out_norm_b[l])], axis=-1)
        y = jnp.einsum('bse,ed->bsd', mixed, w_out[l])
        x = x + rmsnorm(y, post_mix_norm[l])
        h = rmsnorm(x, pre_ffn_norm[l])
        f = conv_ffn(h, w_up[l], conv_w[l], conv_b[l], w_down[l])
        x = x + rmsnorm(f, post_ffn_norm[l])
    return x
```

```cpp
#include <hip/hip_runtime.h>
#include <hip/hip_cooperative_groups.h>
#include <cstdio>
#include <cstdint>
namespace cg = cooperative_groups;
namespace pg8 {
#define PG8_LAS __attribute__((address_space(3)))
typedef unsigned short bf16_t;
typedef short bf16x8 __attribute__((ext_vector_type(8)));
typedef float f32x4 __attribute__((ext_vector_type(4)));
typedef unsigned u32x4 __attribute__((ext_vector_type(4)));
constexpr int BM = 256, BK = 64, HALF = 128, HTB = HALF * BK * 2  , STAGE_BYTES = 8 * HTB, NXCD = 8, WGM = 8;

__host__ __device__ __forceinline__ int lds_byte(int r, int c) { const int st = (r >> 4) * 2 + (c >> 5), rr = r & 15, cc = c & 31, ob = rr * 64 + cc * 2; return st * 1024 + (ob ^ (((ob >> 9) & 1) << 5)); }
__host__ __device__ __forceinline__ void stage_rc(int b, int& R, int& C) { const int st = b / 1024, sb = b % 1024, swz = sb ^ (((sb >> 9) & 1) << 5); R = (st >> 1) * 16 + swz / 64; C = (st & 1) * 32 + (swz % 64) / 2; }
__host__ __device__ __forceinline__ int perm32(int rho) { const int n = rho >> 4, i = rho & 15; return 8 * (i >> 2) + 4 * n + (i & 3); }

struct Unit { int pm, pn; };
struct Gemm { const bf16_t* A; const bf16_t* Bt; int M, N, K; };

struct StaticOrder {
    int nM, nN, nwg, G, c;
    __host__ __device__ void init(int M, int N, int G_, int c_) { nM = M / BM; nN = N / BM; nwg = nM * nN; G = G_; c = c_; }
    __host__ __device__ bool next(int i, Unit& u) const {
        const long L = (long)i * G + c; if (L >= nwg) return false;
        int wgid = (int)L; { const int q = nwg / NXCD, r = nwg % NXCD, xcd = wgid % NXCD, off = wgid / NXCD; wgid = (xcd < r ? xcd * (q + 1) : r * (q + 1) + (xcd - r) * q) + off; }
        const int nig = WGM * nN, gid = wgid / nig, fm = gid * WGM, gsz = (nM - fm) < WGM ? (nM - fm) : WGM;
        u.pm = fm + ((wgid % nig) % gsz); u.pn = (wgid % nig) / gsz; return true;
    }
    __device__ __forceinline__ void a_ready(const Unit&) const {}
    __device__ __forceinline__ void done(const Unit&) const {}
};

__device__ __forceinline__ unsigned cvt_pk_bf16(float lo, float hi) { unsigned r; asm volatile("v_cvt_pk_bf16_f32 %0, %1, %2" : "=v"(r) : "v"(lo), "v"(hi)); return r; }
typedef float f32x2 __attribute__((ext_vector_type(2)));
__device__ __forceinline__ f32x2 gelu_pk(f32x2 v) {
    const f32x2 av = __builtin_elementwise_abs(v), d = av * 0.2316418882f + 1.0f;
    f32x2 t; t.x = __builtin_amdgcn_rcpf(d.x); t.y = __builtin_amdgcn_rcpf(d.y);
    f32x2 q = t * 0.5307027145f + (-0.7265760135f); q = q * t + 0.7107068705f; q = q * t + (-0.142248368f); q = q * t + 0.127414796f; q = q * t;
    const f32x2 s = (v * v) * (-0.72134752044f);
    f32x2 e; e.x = __builtin_amdgcn_exp2f(s.x); e.y = __builtin_amdgcn_exp2f(s.y);
    const f32x2 m = v * (q * e), r = v - m;
    f32x2 o; o.x = v.x < 0.f ? m.x : r.x; o.y = v.y < 0.f ? m.y : r.y; return o;
}

template <int ACT  > struct EpiBf16 {
    static constexpr bool PERM = true, AFTER_DRAIN = false; static_assert(ACT == 0 || ACT == 1, "EpiBf16: ACT is 0 (none) or 1 (gelu_pk)");
    bf16_t* O; int ldc; const float* bias; int split_cols; size_t split_stride; float scale0;
    __device__ __forceinline__ void operator()(const f32x4 (&acc)[2][2][4][2], const Unit& u, int wr, int wc, int fr, int fq) const {
        const int row0 = u.pm * BM + wr * 64 + fr; int colt = u.pn * BM; bf16_t* base = O;
        float sc = 1.f; if (split_cols) { const int t = colt / split_cols; base += (size_t)t * split_stride; colt -= t * split_cols; if (t == 0) sc = scale0; }
        const int col0 = colt + wc * 32 + 8 * fq, bcol0 = u.pn * BM + wc * 32 + 8 * fq;
        f32x4 bv[2][2];
#pragma unroll
        for (int bj = 0; bj < 2; ++bj)
#pragma unroll
            for (int n = 0; n < 2; ++n) bv[bj][n] = bias ? *(const f32x4*)(bias + bcol0 + bj * HALF + 4 * n) : (f32x4){0.f, 0.f, 0.f, 0.f};
#pragma unroll
        for (int ai = 0; ai < 2; ++ai)
#pragma unroll
            for (int m = 0; m < 4; ++m) { bf16_t* rowp = base + (size_t)(row0 + ai * HALF + m * 16) * ldc + col0;
#pragma unroll
                for (int bj = 0; bj < 2; ++bj) { f32x4 v0 = acc[ai][bj][m][0] + bv[bj][0], v1 = acc[ai][bj][m][1] + bv[bj][1];
                    if (ACT == 1) { f32x2 a = gelu_pk((f32x2){v0[0], v0[1]}), b = gelu_pk((f32x2){v0[2], v0[3]}), c = gelu_pk((f32x2){v1[0], v1[1]}), d = gelu_pk((f32x2){v1[2], v1[3]});
                        v0 = (f32x4){a.x, a.y, b.x, b.y}; v1 = (f32x4){c.x, c.y, d.x, d.y}; }
                    v0 = v0 * sc; v1 = v1 * sc; u32x4 w; w.x = cvt_pk_bf16(v0[0], v0[1]); w.y = cvt_pk_bf16(v0[2], v0[3]); w.z = cvt_pk_bf16(v1[0], v1[1]); w.w = cvt_pk_bf16(v1[2], v1[3]);
                    *(u32x4*)(rowp + bj * HALF) = w; } }
    }
};

__device__ __forceinline__ float shx(float v, int m, int lane) { return __builtin_bit_cast(float, __builtin_amdgcn_ds_bpermute((lane ^ m) << 2, __builtin_bit_cast(int, v))); }
__device__ __forceinline__ float gelu_tanh_f(float x) {
    const float u = 0.7978845608028654f * (x + 0.044715f * x * x * x);
    const float e = __builtin_amdgcn_exp2f(-2.8853900817779268f * u);
    return x * __builtin_amdgcn_rcpf(1.0f + e);
}
struct EpiProj {
    static constexpr bool PERM = true, AFTER_DRAIN = false;
    bf16_t* O; const float* rope;
    __device__ __forceinline__ void operator()(const f32x4 (&acc)[2][2][4][2], const Unit& u, int wr, int wc, int fr, int fq) const {
        const int row0 = u.pm * BM + wr * 64 + fr; const int col0 = u.pn * BM + wc * 32 + 8 * fq;
        const int kind = u.pn < 4 ? 0 : (u.pn < 8 ? 1 : 2);
        const float qs = (u.pn < 6) ? 0.125f : 1.0f;
        const bool ropelane = ((wc & 1) == 0) && (fq < 2);
        const float sgn = (fq == 0) ? -1.0f : 1.0f;
#pragma unroll
        for (int ai = 0; ai < 2; ++ai)
#pragma unroll
            for (int m = 0; m < 4; ++m) {
                const int row = row0 + ai * HALF + m * 16;
                bf16_t* rowp = O + (size_t)row * 2560 + col0;
                f32x4 c0 = {1.f, 1.f, 1.f, 1.f}, c1 = c0, s0 = {0.f, 0.f, 0.f, 0.f}, s1 = s0;
                if (kind == 1 && ropelane) { const float* rp = rope + (size_t)(row & 4095) * 16;
                    c0 = *(const f32x4*)(rp); c1 = *(const f32x4*)(rp + 4); s0 = *(const f32x4*)(rp + 8); s1 = *(const f32x4*)(rp + 12); s0 = s0 * sgn; s1 = s1 * sgn; }
#pragma unroll
                for (int bj = 0; bj < 2; ++bj) {
                    f32x4 v0 = acc[ai][bj][m][0], v1 = acc[ai][bj][m][1];
                    if (kind == 0) {
                        f32x2 a = gelu_pk((f32x2){v0[0], v0[1]}), b = gelu_pk((f32x2){v0[2], v0[3]}), c = gelu_pk((f32x2){v1[0], v1[1]}), d = gelu_pk((f32x2){v1[2], v1[3]});
                        v0 = (f32x4){a.x, a.y, b.x, b.y}; v1 = (f32x4){c.x, c.y, d.x, d.y};
                    } else if (kind == 1) {
                        f32x4 p0, p1;
#pragma unroll
                        for (int e = 0; e < 4; ++e) { p0[e] = shx(v0[e], 16, fq * 16 + fr); p1[e] = shx(v1[e], 16, fq * 16 + fr); }
                        v0 = (v0 * c0 + p0 * s0) * qs; v1 = (v1 * c1 + p1 * s1) * qs;
                    }
                    u32x4 w; w.x = cvt_pk_bf16(v0[0], v0[1]); w.y = cvt_pk_bf16(v0[2], v0[3]); w.z = cvt_pk_bf16(v1[0], v1[1]); w.w = cvt_pk_bf16(v1[2], v1[3]);
                    *(u32x4*)(rowp + bj * HALF) = w;
                }
                asm volatile("" ::: "memory");
            }
    }
};
__device__ __forceinline__ float dpp_ror1(float v) { return __builtin_bit_cast(float, __builtin_amdgcn_update_dpp(0, __builtin_bit_cast(int, v), 0x121, 0xf, 0xf, false)); }
__device__ __forceinline__ float dpp_ror2(float v) { return __builtin_bit_cast(float, __builtin_amdgcn_update_dpp(0, __builtin_bit_cast(int, v), 0x122, 0xf, 0xf, false)); }
struct EpiUp {
    static constexpr bool PERM = true, AFTER_DRAIN = false;
    bf16_t* H; const float* cw; const float* cb; PG8_LAS float* bnd;
    __device__ __forceinline__ void operator()(const f32x4 (&acc)[2][2][4][2], const Unit& u, int wr, int wc, int fr, int fq) const {
        const int par = u.pm & 1;
        PG8_LAS float* bw = bnd + par * 2048; PG8_LAS float* bo = bnd + (par ^ 1) * 2048;
        const int lc = wc * 32 + 8 * fq;
        if (fr >= 14) {
#pragma unroll
            for (int ai = 0; ai < 2; ++ai)
#pragma unroll
                for (int bj = 0; bj < 2; ++bj)
#pragma unroll
                    for (int n = 0; n < 2; ++n) *(PG8_LAS f32x4*)(bw + ((2 * ai + wr) * 2 + (fr - 14)) * 256 + bj * HALF + lc + 4 * n) = acc[ai][bj][3][n];
        }
        asm volatile("s_waitcnt lgkmcnt(0)" ::: "memory"); __builtin_amdgcn_s_barrier(); asm volatile("" ::: "memory");
        const bool first = (u.pm & 15) == 0;
        const int prow = fr >= 14 ? fr - 14 : 0;
        typedef float f32x2v __attribute__((ext_vector_type(2)));
#pragma unroll
        for (int n = 0; n < 2; ++n)
#pragma unroll
        for (int jp = 0; jp < 2; ++jp) {
            const int f0 = u.pn * HALF + lc + 4 * n + 2 * jp;
            const f32x2v wg0 = *(const f32x2v*)(cw + f0), wg1 = *(const f32x2v*)(cw + 8192 + f0), wg2 = *(const f32x2v*)(cw + 16384 + f0), bg = *(const f32x2v*)(cb + f0);
            const f32x2v wv0 = *(const f32x2v*)(cw + 4096 + f0), wv1 = *(const f32x2v*)(cw + 8192 + 4096 + f0), wv2 = *(const f32x2v*)(cw + 16384 + 4096 + f0), bv = *(const f32x2v*)(cb + 4096 + f0);
#pragma unroll
            for (int ai = 0; ai < 2; ++ai) {
                const int g = 2 * ai + wr;
                f32x2v pg = {0.f, 0.f}, pv = pg;
                if (g == 0) { if (!first) { pg = *(PG8_LAS f32x2v*)(bo + (3 * 2 + prow) * 256 + lc + 4 * n + 2 * jp); pv = *(PG8_LAS f32x2v*)(bo + (3 * 2 + prow) * 256 + HALF + lc + 4 * n + 2 * jp); } }
                else { pg = *(PG8_LAS f32x2v*)(bw + ((g - 1) * 2 + prow) * 256 + lc + 4 * n + 2 * jp); pv = *(PG8_LAS f32x2v*)(bw + ((g - 1) * 2 + prow) * 256 + HALF + lc + 4 * n + 2 * jp); }
#pragma unroll
                for (int m = 0; m < 4; ++m) {
                    float y[2];
#pragma unroll
                    for (int jj = 0; jj < 2; ++jj) {
                        const int j = 2 * jp + jj;
                        const float a = acc[ai][0][m][n][j], b = acc[ai][1][m][n][j];
                        const float qa = (m == 0) ? pg[jj] : acc[ai][0][m == 0 ? 0 : m - 1][n][j], qb = (m == 0) ? pv[jj] : acc[ai][1][m == 0 ? 0 : m - 1][n][j];
                        const float a1c = dpp_ror1(a), a2c = dpp_ror2(a), a1p = dpp_ror1(qa), a2p = dpp_ror2(qa);
                        const float b1c = dpp_ror1(b), b2c = dpp_ror2(b), b1p = dpp_ror1(qb), b2p = dpp_ror2(qb);
                        const float a1 = (fr == 0) ? a1p : a1c, a2 = (fr < 2) ? a2p : a2c;
                        const float b1 = (fr == 0) ? b1p : b1c, b2 = (fr < 2) ? b2p : b2c;
                        const float gcv = bg[jj] + wg0[jj] * a2 + wg1[jj] * a1 + wg2[jj] * a;
                        const float vcv = bv[jj] + wv0[jj] * b2 + wv1[jj] * b1 + wv2[jj] * b;
                        y[jj] = gelu_tanh_f(gcv) * vcv;
                    }
                    const int row = u.pm * BM + ai * HALF + wr * 64 + m * 16 + fr;
                    *(unsigned*)(H + (size_t)row * 4096 + f0) = cvt_pk_bf16(y[0], y[1]);
                }
            }
            asm volatile("" ::: "memory");
        }
    }
};
struct UpOrder {
    int G, c;
    __device__ bool next(int i, Unit& u) const {
        const int run = c + (i >> 4) * G; if (run >= 256) return false;
        const int xcd = run & 7, idx = run >> 3;
        u.pn = xcd * 4 + (idx & 3); u.pm = (idx >> 2) * 16 + (i & 15); return true;
    }
    __device__ __forceinline__ void a_ready(const Unit&) const {}
    __device__ __forceinline__ void done(const Unit&) const {}
};


struct EpiAny {
    static constexpr bool PERM = true, AFTER_DRAIN = false;
    int kind; bf16_t* O; const float* a0; const float* a1; PG8_LAS float* bnd;
    __device__ __forceinline__ void operator()(const f32x4 (&acc)[2][2][4][2], const Unit& u, int wr, int wc, int fr, int fq) const {
        if (kind == 0) { const EpiProj e{O, a0}; e(acc, u, wr, wc, fr, fq); }
        else if (kind == 1) { const EpiBf16<0> e{O, 1024, nullptr, 0, 0, 1.f}; e(acc, u, wr, wc, fr, fq); }
        else { const EpiUp e{O, a0, a1, bnd}; e(acc, u, wr, wc, fr, fq); }
    }
};
struct AnyOrder {
    int mode; StaticOrder so; UpOrder uo;
    __device__ __forceinline__ bool next(int i, Unit& u) const { return mode ? uo.next(i, u) : so.next(i, u); }
    __device__ __forceinline__ void a_ready(const Unit&) const {}
    __device__ __forceinline__ void done(const Unit&) const {}
};
template <class Epi, class Sched, bool ALIGN_EPI = false, bool SP2 = false>
__device__ __forceinline__ void gemm_phase(PG8_LAS unsigned char* lds, const Gemm g, const Sched& S, const Epi& E, const int tid) {
    const int wid = __builtin_amdgcn_readfirstlane(tid >> 6), lane = tid & 63, wr = wid >> 2, wc = wid & 3, fr = lane & 15, fq = lane >> 4;
    const int K = g.K, nt = K / BK;
    unsigned voffA[2], voffB[2];
#pragma unroll
    for (int i = 0; i < 2; ++i) { int R, C; stage_rc(tid * 16 + i * 8192, R, C); const int Rb = Epi::PERM ? ((R & ~31) + perm32(R & 31)) : R;
        voffA[i] = (unsigned)(R * K + C) * 2u; voffB[i] = (unsigned)(Rb * K + C) * 2u; }
    const size_t kstep = (size_t)(BK * 2);
    const size_t hstep = (size_t)HALF * K * 2;
    const size_t tstep = 2 * hstep;
    const unsigned ldsw = (unsigned)wid * 1024u;
    const int aoff = lds_byte(wr * 64 + fr, fq * 8), boff = lds_byte(wc * 32 + fr, fq * 8);
#define PG8_SA(b, h) (((b) * 2 + (h)) * HTB)
#define PG8_SB(b, h) ((4 + (b) * 2 + (h)) * HTB)
#define PG8_STAGE(bufoff, gbase, voff) do { _Pragma("unroll") for (int _i = 0; _i < 2; ++_i) \
        __builtin_amdgcn_global_load_lds((const unsigned*)((const char*)(gbase) + (voff)[_i]), (PG8_LAS unsigned*)(lds + (bufoff) + ldsw + _i * 8192), 16, 0, 0); } while (0)
#define PG8_LDA(dst, b, h) do { _Pragma("unroll") for (int m = 0; m < 4; ++m) _Pragma("unroll") for (int k = 0; k < 2; ++k) dst[m][k] = *(const PG8_LAS bf16x8*)(lds + PG8_SA(b, h) + aoff + m * 2048 + k * 1024); } while (0)
#define PG8_LDB(dst, b, h) do { _Pragma("unroll") for (int n = 0; n < 2; ++n) _Pragma("unroll") for (int k = 0; k < 2; ++k) dst[n][k] = *(const PG8_LAS bf16x8*)(lds + PG8_SB(b, h) + boff + n * 2048 + k * 1024); } while (0)
#define PG8_MMA(ai, bj, At, Bt) do { __builtin_amdgcn_s_setprio(1); _Pragma("unroll") for (int m = 0; m < 4; ++m) _Pragma("unroll") for (int n = 0; n < 2; ++n) _Pragma("unroll") for (int k = 0; k < 2; ++k) \
        acc[ai][bj][m][n] = __builtin_amdgcn_mfma_f32_16x16x32_bf16(Bt[n][k], At[m][k], acc[ai][bj][m][n], 0, 0, 0); __builtin_amdgcn_s_setprio(0); } while (0)
#define PG8_WAIT_V(n) asm volatile("s_waitcnt vmcnt(" #n ")" ::: "memory")
#define PG8_WAIT_L(n) asm volatile("s_waitcnt lgkmcnt(" #n ")" ::: "memory")
#define PG8_BAR __builtin_amdgcn_s_barrier()
#define PG8_SCHED __builtin_amdgcn_sched_barrier(0)
    Unit cur, nxt; int ui = 0;
    if (!S.next(0, cur)) return;
    f32x4 acc[2][2][4][2];
#pragma unroll
    for (int a = 0; a < 2; ++a)
#pragma unroll
        for (int b = 0; b < 2; ++b)
#pragma unroll
            for (int m = 0; m < 4; ++m)
#pragma unroll
                for (int n = 0; n < 2; ++n) acc[a][b][m][n] = (f32x4){0.f, 0.f, 0.f, 0.f};
    bf16x8 At[4][2], B0[2][2], B1[2][2];
    const char* cA = (const char*)g.A + (size_t)cur.pm * tstep; const char* cB = (const char*)g.Bt + (size_t)cur.pn * tstep;
    S.a_ready(cur);
    if constexpr (SP2) {
        PG8_STAGE(PG8_SB(0, 0), cB, voffB); PG8_STAGE(PG8_SB(0, 1), cB + hstep, voffB); PG8_STAGE(PG8_SA(0, 0), cA, voffA); PG8_STAGE(PG8_SA(0, 1), cA + hstep, voffA);
        if (wr == 1) PG8_BAR;
        PG8_WAIT_V(2); PG8_BAR;
        PG8_STAGE(PG8_SB(1, 0), cB + kstep, voffB); PG8_STAGE(PG8_SA(1, 0), cA + kstep, voffA); PG8_STAGE(PG8_SB(1, 1), cB + hstep + kstep, voffB);
        PG8_WAIT_V(6); PG8_BAR;
    } else {
        PG8_STAGE(PG8_SB(0, 0), cB, voffB); PG8_STAGE(PG8_SA(0, 0), cA, voffA); PG8_STAGE(PG8_SB(0, 1), cB + hstep, voffB); PG8_STAGE(PG8_SA(0, 1), cA + hstep, voffA);
        if (wr == 1) PG8_BAR;
        PG8_WAIT_V(4); PG8_BAR;
        PG8_STAGE(PG8_SB(1, 0), cB + kstep, voffB); PG8_STAGE(PG8_SA(1, 0), cA + kstep, voffA); PG8_STAGE(PG8_SB(1, 1), cB + hstep + kstep, voffB);
        PG8_WAIT_V(6); PG8_BAR;
    }
    for (;;) {
        const bool has_next = S.next(ui + 1, nxt);
        const char* nA = has_next ? (const char*)g.A + (size_t)nxt.pm * tstep : cA; const char* nB = has_next ? (const char*)g.Bt + (size_t)nxt.pn * tstep : cB;
        for (int t = 0; t < nt; t += 2) {
            const bool last = (t == nt - 2);
            const char* a1 = cA + (size_t)(t + 1) * kstep;
            const char* a2 = last ? nA : cA + (size_t)(t + 2) * kstep; const char* b2 = last ? nB : cB + (size_t)(t + 2) * kstep;
            const char* a3 = a2 + kstep; const char* b3 = b2 + kstep;
            if (last && has_next) S.a_ready(nxt);
            if constexpr (SP2) {
            PG8_LDB(B0, 0, 0); PG8_LDB(B1, 0, 1); PG8_SCHED; PG8_LDA(At, 0, 0); PG8_STAGE(PG8_SA(1, 1), a1 + hstep, voffA);
            PG8_WAIT_V(8); PG8_WAIT_L(0); PG8_BAR; PG8_MMA(0, 0, At, B0); PG8_MMA(0, 1, At, B1); PG8_BAR; PG8_SCHED;
            PG8_LDA(At, 0, 1); PG8_STAGE(PG8_SB(0, 0), b2, voffB); PG8_STAGE(PG8_SB(0, 1), b2 + hstep, voffB); PG8_STAGE(PG8_SA(0, 0), a2, voffA);
            PG8_WAIT_V(8); PG8_WAIT_L(0); PG8_BAR; PG8_MMA(1, 0, At, B0); PG8_MMA(1, 1, At, B1); PG8_BAR; PG8_SCHED;
            PG8_LDB(B0, 1, 0); PG8_LDB(B1, 1, 1); PG8_SCHED; PG8_LDA(At, 1, 0); PG8_STAGE(PG8_SA(0, 1), a2 + hstep, voffA);
            PG8_WAIT_V(8); PG8_WAIT_L(0); PG8_BAR; PG8_MMA(0, 0, At, B0); PG8_MMA(0, 1, At, B1); PG8_BAR; PG8_SCHED;
            PG8_LDA(At, 1, 1); PG8_STAGE(PG8_SB(1, 0), b3, voffB); PG8_STAGE(PG8_SB(1, 1), b3 + hstep, voffB); PG8_STAGE(PG8_SA(1, 0), a3, voffA);
            PG8_WAIT_V(8); PG8_WAIT_L(0); PG8_BAR; PG8_MMA(1, 0, At, B0); PG8_MMA(1, 1, At, B1); PG8_BAR; PG8_SCHED;
            } else {
            PG8_LDB(B0, 0, 0); PG8_SCHED; PG8_LDA(At, 0, 0); PG8_STAGE(PG8_SA(1, 1), a1 + hstep, voffA);
            PG8_WAIT_L(8); PG8_BAR; PG8_WAIT_L(0); PG8_MMA(0, 0, At, B0); PG8_BAR; PG8_SCHED;
            PG8_LDB(B1, 0, 1); PG8_STAGE(PG8_SB(0, 0), b2, voffB);
            PG8_BAR; PG8_WAIT_L(0); PG8_MMA(0, 1, At, B1); PG8_BAR;
            PG8_LDA(At, 0, 1); PG8_STAGE(PG8_SA(0, 0), a2, voffA);
            PG8_BAR; PG8_WAIT_L(0); PG8_MMA(1, 0, At, B0); PG8_BAR; PG8_SCHED;
            PG8_STAGE(PG8_SB(0, 1), b2 + hstep, voffB);
            PG8_WAIT_V(6); PG8_BAR; PG8_MMA(1, 1, At, B1); PG8_BAR;
            PG8_LDB(B0, 1, 0); PG8_SCHED; PG8_LDA(At, 1, 0); PG8_STAGE(PG8_SA(0, 1), a2 + hstep, voffA);
            PG8_WAIT_L(8); PG8_BAR; PG8_WAIT_L(0); PG8_MMA(0, 0, At, B0); PG8_BAR; PG8_SCHED;
            PG8_LDB(B1, 1, 1); PG8_STAGE(PG8_SB(1, 0), b3, voffB);
            PG8_BAR; PG8_WAIT_L(0); PG8_MMA(0, 1, At, B1); PG8_BAR;
            PG8_LDA(At, 1, 1); PG8_STAGE(PG8_SA(1, 0), a3, voffA);
            PG8_BAR; PG8_WAIT_L(0); PG8_MMA(1, 0, At, B0); PG8_BAR; PG8_SCHED;
            PG8_STAGE(PG8_SB(1, 1), b3 + hstep, voffB);
            PG8_WAIT_V(6); PG8_BAR; PG8_MMA(1, 1, At, B1); PG8_BAR;
            }
        }
        if constexpr (ALIGN_EPI) { if (wr == 0) PG8_BAR; }
        if constexpr (!Epi::AFTER_DRAIN) { E(acc, cur, wr, wc, fr, fq); S.done(cur); }
        if (!has_next) break;
#pragma unroll
        for (int a = 0; a < 2; ++a)
#pragma unroll
            for (int b = 0; b < 2; ++b)
#pragma unroll
                for (int m = 0; m < 4; ++m)
#pragma unroll
                    for (int n = 0; n < 2; ++n) acc[a][b][m][n] = (f32x4){0.f, 0.f, 0.f, 0.f};
        cur = nxt; cA = nA; cB = nB; ++ui;
        if constexpr (ALIGN_EPI) { if (wr == 1) PG8_BAR; }
    }
    PG8_WAIT_V(0);
    if constexpr (!ALIGN_EPI) { if (wr == 0) PG8_BAR; }
    PG8_BAR;
    if constexpr (Epi::AFTER_DRAIN) { E.fused(acc, cur, wr, wc, fr, fq, lds, wid, lane); S.done(cur); }
#undef PG8_SA
#undef PG8_SB
#undef PG8_STAGE
#undef PG8_LDA
#undef PG8_LDB
#undef PG8_MMA
#undef PG8_WAIT_V
#undef PG8_WAIT_L
#undef PG8_BAR
#undef PG8_SCHED
}
}

constexpr int NWAVES = 8, NTHR = NWAVES * 64;
constexpr int BATCH = 8, SEQ = 4096, DM = 1024, TOK = BATCH * SEQ, INC = 2560, AW = 512, DFF = 4096, NLAYER = 2;
constexpr float EPS = 1e-6f;
constexpr size_t MiB = 1u << 20;
constexpr size_t WS_WIN = 1 * MiB, WS_WOUT = 11 * MiB, WS_WUP = 15 * MiB, WS_WDN = 47 * MiB, WS_ROPE = 63 * MiB;
constexpr size_t WS_HB = 64 * MiB;
constexpr size_t WS_HID = 128 * MiB;
constexpr size_t WS_PROJ = 128 * MiB;
constexpr size_t WS_OP = 288 * MiB;
constexpr size_t WS_Y1 = 128 * MiB;
constexpr size_t WS_MIXED = 384 * MiB;
constexpr size_t WS_Y2 = 384 * MiB;
constexpr size_t WS_LSE = 448 * MiB;
constexpr size_t WS_END = 452 * MiB;
constexpr int LDS_BYTES = 147456;
constexpr int BND_OFF = 131072;

#define LAS __attribute__((address_space(3)))
#define KAS __attribute__((address_space(4)))
typedef unsigned short bf16;
typedef unsigned u32x4 __attribute__((ext_vector_type(4)));
typedef unsigned u32x2 __attribute__((ext_vector_type(2)));
typedef float f32x4 __attribute__((ext_vector_type(4)));
typedef short bf16x8 __attribute__((ext_vector_type(8)));
typedef short bf16x4 __attribute__((ext_vector_type(4)));

__device__ __forceinline__ float bflo(unsigned w) { return __builtin_bit_cast(float, w << 16); }
__device__ __forceinline__ float bfhi(unsigned w) { return __builtin_bit_cast(float, w & 0xffff0000u); }
__device__ __forceinline__ unsigned pk2(float lo, float hi) { return pg8::cvt_pk_bf16(lo, hi); }
__device__ __forceinline__ float wave_sum(float v, int lane) {
#pragma unroll
    for (int o = 1; o < 64; o <<= 1) v += pg8::shx(v, o, lane);
    return v;
}
__device__ __forceinline__ float dot4(f32x4 a) { return (a[0] * a[0] + a[1] * a[1]) + (a[2] * a[2] + a[3] * a[3]); }
#define WG_BARRIER() do { asm volatile("s_waitcnt vmcnt(0) lgkmcnt(0)" ::: "memory"); __builtin_amdgcn_s_barrier(); asm volatile("" ::: "memory"); } while (0)

__device__ __forceinline__ void transpose_item(const float* W, int K, int N, bf16* WT, int k0, int n0, int drow0, LAS float* scr, int lane) {
#pragma unroll 8
    for (int i = 0; i < 32; ++i) { const int kk = 2 * i + (lane >> 5); scr[kk * 33 + (lane & 31)] = W[(size_t)(k0 + kk) * N + n0 + (lane & 31)]; }
    asm volatile("s_waitcnt lgkmcnt(0)" ::: "memory");
    const int c = lane & 7;
#pragma unroll
    for (int j = 0; j < 4; ++j) { const int n = (lane >> 3) + 8 * j; const LAS float* s = scr + (8 * c) * 33 + n;
        u32x4 o; o.x = pk2(s[0 * 33], s[1 * 33]); o.y = pk2(s[2 * 33], s[3 * 33]); o.z = pk2(s[4 * 33], s[5 * 33]); o.w = pk2(s[6 * 33], s[7 * 33]);
        *(u32x4*)(WT + (size_t)(drow0 + n) * K + k0 + 8 * c) = o; }
    asm volatile("s_waitcnt lgkmcnt(0)" ::: "memory");
}
__device__ __forceinline__ void rms_row_to_bf16(const float* xrow, const float* g, bf16* orow, int lane) {
    const f32x4* xr = (const f32x4*)xrow + lane; const f32x4* gr = (const f32x4*)g + lane;
    f32x4 v[4]; float s = 0.f;
#pragma unroll
    for (int j = 0; j < 4; ++j) { v[j] = xr[64 * j]; s += dot4(v[j]); }
    const float rstd = 1.0f / sqrtf(wave_sum(s, lane) * (1.0f / DM) + EPS);
    u32x2* o8 = (u32x2*)orow + lane;
#pragma unroll
    for (int j = 0; j < 4; ++j) { const f32x4 gg = gr[64 * j]; const f32x4 y = v[j] * rstd * gg; u32x2 w; w.x = pk2(y[0], y[1]); w.y = pk2(y[2], y[3]); o8[64 * j] = w; }
}
struct Args { const float* in[17]; float* out; unsigned char* ws; int ph_lo, ph_hi; };
__device__ __forceinline__ void prologue(const float* x, const float* g0, const float* w_in, const float* w_out, const float* w_up, const float* w_dn, unsigned char* ws_, LAS unsigned char* lds, int gw, int NGW, int wave, int lane) {
    LAS float* scr = (LAS float*)(lds + wave * 16384);
    constexpr int I_IN = 16 * 80, I_OUT = 16 * 32, I_UP = 16 * 256, I_DN = 64 * 32, I_L = I_IN + I_OUT + I_UP + I_DN;
    for (int it = gw; it < NLAYER * I_L; it += NGW) {
        const int l = it / I_L; int r = it % I_L;
        if (r < I_IN) { const int nb = r % 80, kb = r / 80;
            transpose_item(w_in + (size_t)l * DM * INC, DM, INC, (bf16*)(ws_ + WS_WIN) + (size_t)l * INC * DM, 64 * kb, 32 * nb, 32 * nb, scr, lane); continue; }
        r -= I_IN;
        if (r < I_OUT) { const int nb = r % 32, kb = r / 32;
            transpose_item(w_out + (size_t)l * DM * DM, DM, DM, (bf16*)(ws_ + WS_WOUT) + (size_t)l * DM * DM, 64 * kb, 32 * nb, 32 * nb, scr, lane); continue; }
        r -= I_OUT;
        if (r < I_UP) { const int nb = r % 256, kb = r / 256; const int n0 = 32 * nb; const int f0 = n0 & 4095;
            const int drow0 = (f0 >> 7) * 256 + (n0 >= 4096 ? 128 : 0) + (f0 & 127);
            transpose_item(w_up + (size_t)l * DM * 2 * DFF, DM, 2 * DFF, (bf16*)(ws_ + WS_WUP) + (size_t)l * 2 * DFF * DM, 64 * kb, n0, drow0, scr, lane); continue; }
        r -= I_UP;
        { const int nb = r % 32, kb = r / 32;
            transpose_item(w_dn + (size_t)l * DFF * DM, DFF, DM, (bf16*)(ws_ + WS_WDN) + (size_t)l * DM * DFF, 64 * kb, 32 * nb, 32 * nb, scr, lane); }
    }
    for (int m = gw; m < TOK; m += NGW) rms_row_to_bf16(x + (size_t)m * DM, g0, (bf16*)(ws_ + WS_HB) + (size_t)m * DM, lane);
    float* rope = (float*)(ws_ + WS_ROPE);
    for (int e = gw * 64 + lane; e < SEQ * 8; e += NGW * 64) { const int s = e >> 3, i = e & 7;
        const float inv = i == 0 ? 1.0f : i == 1 ? 0.19392274f : i == 2 ? 0.03760603f : i == 3 ? 0.0072926646f : i == 4 ? 0.0014142136f : i == 5 ? 0.0002742482f : i == 6 ? 5.3182957e-05f : 1.0313385e-05f;
        const float ang = (float)s * inv;
        const float chi = 0.15915494f, clo = 6.4206382e-09f;
        const float hi = ang * chi; const float lo = __builtin_fmaf(ang, chi, -hi) + ang * clo;
        float fr_ = __builtin_amdgcn_fractf(hi) + lo;
        rope[s * 16 + i] = __builtin_amdgcn_cosf(fr_); rope[s * 16 + 8 + i] = __builtin_amdgcn_sinf(fr_); }
}

__device__ __forceinline__ void mixA_chunk(LAS unsigned char* lds, int chunk, const bf16* PROJ, const float* vg, const float* vb, const float* wsp, const float* bsp, const float* ga,
                                           bf16* MIXED, int tid, int wid, int lane) {
    LAS bf16* wsL = (LAS bf16*)lds;
    LAS bf16* vnT = (LAS bf16*)(lds + 34816);
    LAS float* stat = (LAS float*)(lds + 69632);
    const int t0 = chunk * 128, fr = lane & 15, fq = lane >> 4;
    WG_BARRIER();
    for (int i = 0; i < 16; ++i) { const int tk = 16 * wid + i;
        const u32x4 raw = *(const u32x4*)(PROJ + (size_t)(t0 + tk) * INC + 512 + 8 * lane);
        float x[8]; x[0] = bflo(raw.x); x[1] = bfhi(raw.x); x[2] = bflo(raw.y); x[3] = bfhi(raw.y); x[4] = bflo(raw.z); x[5] = bfhi(raw.z); x[6] = bflo(raw.w); x[7] = bfhi(raw.w);
        float s = 0.f;
#pragma unroll
        for (int e = 0; e < 8; ++e) s += x[e];
        const float mean = wave_sum(s, lane) * (1.0f / AW); float q = 0.f;
#pragma unroll
        for (int e = 0; e < 8; ++e) { const float d = x[e] - mean; q += d * d; }
        const float rstd = 1.0f / sqrtf(wave_sum(q, lane) * (1.0f / AW) + EPS);
        if (lane == 0) { stat[tk] = mean; stat[128 + tk] = rstd; }
    }
    float ssq = 0.f;
    const int p = 16 * wid + fr; const size_t t = (size_t)(t0 + p);
#pragma unroll 1
    for (int g = 0; g < 4; ++g) {
        WG_BARRIER();
#pragma unroll
        for (int it = 0; it < 8; ++it) { const int idx = (it * NTHR + tid) * 4; const int pp = idx >> 7, q = idx & 127;
            f32x4 w = *(const f32x4*)(wsp + g * 16384 + idx);
#pragma unroll
            for (int e = 0; e < 4; ++e) if (q + e > pp) w[e] = 0.f;
            u32x2 o; o.x = pk2(w[0], w[1]); o.y = pk2(w[2], w[3]); *(LAS u32x2*)(wsL + pp * 136 + q) = o; }
#pragma unroll
        for (int it = 0; it < 4; ++it) { const int id = it * NTHR + tid; const int q = id & 127, ck = id >> 7;
            const u32x4 raw = *(const u32x4*)(PROJ + (size_t)(t0 + q) * INC + 512 + g * 128 + 8 * ck);
            const float mean = stat[q], rstd = stat[128 + q];
            const f32x4 g0 = *(const f32x4*)(vg + g * 128 + 8 * ck), g1 = *(const f32x4*)(vg + g * 128 + 8 * ck + 4), b0 = *(const f32x4*)(vb + g * 128 + 8 * ck), b1 = *(const f32x4*)(vb + g * 128 + 8 * ck + 4);
            float x[8]; x[0] = bflo(raw.x); x[1] = bfhi(raw.x); x[2] = bflo(raw.y); x[3] = bfhi(raw.y); x[4] = bflo(raw.z); x[5] = bfhi(raw.z); x[6] = bflo(raw.w); x[7] = bfhi(raw.w);
#pragma unroll
            for (int e = 0; e < 8; ++e) { const float gg = e < 4 ? g0[e & 3] : g1[e & 3], bb = e < 4 ? b0[e & 3] : b1[e & 3];
                const float v = (x[e] - mean) * rstd * gg + bb; vnT[(8 * ck + e) * 136 + q] = (bf16)(pk2(v, 0.f) & 0xffffu); } }
        WG_BARRIER();
        f32x4 acc[8];
#pragma unroll
        for (int cb = 0; cb < 8; ++cb) acc[cb] = (f32x4){0.f, 0.f, 0.f, 0.f};
#pragma unroll
        for (int kk = 0; kk < 4; ++kk) {
            if (32 * kk <= 16 * wid + 15) {
                const bf16x8 y = *(const LAS bf16x8*)(wsL + (16 * wid + fr) * 136 + 32 * kk + 8 * fq);
#pragma unroll
                for (int cb = 0; cb < 8; ++cb) { const bf16x8 x = *(const LAS bf16x8*)(vnT + (16 * cb + fr) * 136 + 32 * kk + 8 * fq);
                    acc[cb] = __builtin_amdgcn_mfma_f32_16x16x32_bf16(x, y, acc[cb], 0, 0, 0); }
            }
        }
        const float bs = bsp[g * 128 + p];
#pragma unroll
        for (int cb = 0; cb < 8; ++cb) { const int ch = g * 128 + 16 * cb + 4 * fq;
            const u32x2 ur = *(const u32x2*)(PROJ + t * INC + ch);
            f32x4 u; u[0] = bflo(ur.x); u[1] = bfhi(ur.x); u[2] = bflo(ur.y); u[3] = bfhi(ur.y);
            const f32x4 o = u * (acc[cb] + bs); ssq += dot4(o);
            u32x2 w; w.x = pk2(o[0], o[1]); w.y = pk2(o[2], o[3]); *(u32x2*)(MIXED + t * DM + ch) = w; }
    }
    asm volatile("s_waitcnt vmcnt(0)" ::: "memory");
    ssq += pg8::shx(ssq, 16, lane); ssq += pg8::shx(ssq, 32, lane);
    const float rs = 1.0f / sqrtf(ssq * (1.0f / AW) + EPS);
#pragma unroll
    for (int g = 0; g < 4; ++g)
#pragma unroll
        for (int cb = 0; cb < 8; ++cb) { const int ch = g * 128 + 16 * cb + 4 * fq; const f32x4 gain = *(const f32x4*)(ga + ch);
            const u32x2 hr = *(const u32x2*)(MIXED + t * DM + ch);
            f32x4 o; o[0] = bflo(hr.x); o[1] = bfhi(hr.x); o[2] = bflo(hr.y); o[3] = bfhi(hr.y); o = o * rs * gain;
            u32x2 w; w.x = pk2(o[0], o[1]); w.y = pk2(o[2], o[3]); *(u32x2*)(MIXED + t * DM + ch) = w; }
}

__device__ __forceinline__ void attn_item(LAS unsigned char* lds, int item, const bf16* PROJ, bf16* OP, float* LSE, int tid, int wid, int lane) {
    LAS bf16* KL = (LAS bf16*)lds;
    LAS bf16* VT = (LAS bf16*)(lds + 36864);
    const int fr = lane & 15, fq = lane >> 4;
    const int bh = item / 96, w96 = item % 96; const int b = bh >> 3, h = bh & 7;
    const int pat = w96 >> 5, within = w96 & 31;
    const int dsh = 2 * pat, d = 1 << dsh, r = within & (d - 1), qb = within >> dsh;
    const size_t rowbase = (size_t)b * SEQ;
    WG_BARRIER();
#pragma unroll
    for (int it = 0; it < 4; ++it) { const int id = it * NTHR + tid; const int j = id >> 3, ck = id & 7;
        const int pos = ((qb - 1) * 128 + j) * d + r;
        u32x4 kv = {0u, 0u, 0u, 0u}, vv = kv;
        if (pos >= 0) { const bf16* rp = PROJ + (rowbase + (size_t)pos) * INC + h * 64 + 8 * ck; kv = *(const u32x4*)(rp + 1536); vv = *(const u32x4*)(rp + 2048); }
        *(LAS u32x4*)(KL + j * 72 + 8 * ck) = kv;
        LAS bf16* vp = VT + (8 * ck) * 264 + j;
        vp[0 * 264] = (bf16)(vv.x & 0xffffu); vp[1 * 264] = (bf16)(vv.x >> 16); vp[2 * 264] = (bf16)(vv.y & 0xffffu); vp[3 * 264] = (bf16)(vv.y >> 16);
        vp[4 * 264] = (bf16)(vv.z & 0xffffu); vp[5 * 264] = (bf16)(vv.z >> 16); vp[6 * 264] = (bf16)(vv.w & 0xffffu); vp[7 * 264] = (bf16)(vv.w >> 16); }
    const int qi = 16 * wid + fr; const int qpos = (qb * 128 + qi) * d + r; const size_t t = rowbase + (size_t)qpos;
    const bf16* qrow = PROJ + t * INC + 1024 + h * 64;
    const bf16x8 q0 = *(const bf16x8*)(qrow + 8 * fq), q1 = *(const bf16x8*)(qrow + 32 + 8 * fq);
    WG_BARRIER();
    f32x4 s[9];
#pragma unroll
    for (int kbi = 0; kbi < 9; ++kbi) { const int kb = wid + kbi;
        const bf16x8 x0 = *(const LAS bf16x8*)(KL + (16 * kb + fr) * 72 + 8 * fq), x1 = *(const LAS bf16x8*)(KL + (16 * kb + fr) * 72 + 32 + 8 * fq);
        f32x4 a = {0.f, 0.f, 0.f, 0.f};
        a = __builtin_amdgcn_mfma_f32_16x16x32_bf16(x0, q0, a, 0, 0, 0); a = __builtin_amdgcn_mfma_f32_16x16x32_bf16(x1, q1, a, 0, 0, 0); s[kbi] = a; }
    float mx = -3.0e38f;
#pragma unroll
    for (int kbi = 0; kbi < 9; ++kbi) {
        const bool blk_ok = (qb > 0) || (wid + kbi >= 8);
#pragma unroll
        for (int e = 0; e < 4; ++e) { const int c = 4 * fq + e;
            bool valid = blk_ok;
            if (kbi == 0) valid = valid && (c >= fr);
            if (kbi == 8) valid = valid && (c <= fr);
            const float v = valid ? s[kbi][e] : -1.0e30f; s[kbi][e] = v; mx = fmaxf(mx, v); }
    }
    mx = fmaxf(mx, pg8::shx(mx, 16, lane)); mx = fmaxf(mx, pg8::shx(mx, 32, lane));
    float l = 0.f; u32x2 pk[10];
#pragma unroll
    for (int kbi = 0; kbi < 9; ++kbi) { float pe[4];
#pragma unroll
        for (int e = 0; e < 4; ++e) { pe[e] = __builtin_amdgcn_exp2f((s[kbi][e] - mx) * 1.4426950408889634f); l += pe[e]; }
        pk[kbi].x = pk2(pe[0], pe[1]); pk[kbi].y = pk2(pe[2], pe[3]); }
    pk[9].x = 0u; pk[9].y = 0u;
    l += pg8::shx(l, 16, lane); l += pg8::shx(l, 32, lane);
    f32x4 oacc[4];
#pragma unroll
    for (int db = 0; db < 4; ++db) oacc[db] = (f32x4){0.f, 0.f, 0.f, 0.f};
#pragma unroll
    for (int pp = 0; pp < 5; ++pp) { const int kbA = wid + 2 * pp; int kbB = kbA + 1; kbB = kbB > 15 ? 15 : kbB;
        u32x4 yy; yy.x = pk[2 * pp].x; yy.y = pk[2 * pp].y; yy.z = pk[2 * pp + 1].x; yy.w = pk[2 * pp + 1].y;
        const bf16x8 yf = __builtin_bit_cast(bf16x8, yy);
#pragma unroll
        for (int db = 0; db < 4; ++db) { const u32x2 xa = *(const LAS u32x2*)(VT + (16 * db + fr) * 264 + 16 * kbA + 4 * fq), xb = *(const LAS u32x2*)(VT + (16 * db + fr) * 264 + 16 * kbB + 4 * fq);
            u32x4 xx; xx.x = xa.x; xx.y = xa.y; xx.z = xb.x; xx.w = xb.y;
            oacc[db] = __builtin_amdgcn_mfma_f32_16x16x32_bf16(__builtin_bit_cast(bf16x8, xx), yf, oacc[db], 0, 0, 0); } }
    const float inv = 1.0f / l;
    bf16* orow = OP + ((size_t)pat * TOK + t) * AW + h * 64 + 4 * fq;
#pragma unroll
    for (int db = 0; db < 4; ++db) { const f32x4 o = oacc[db] * inv; u32x2 w; w.x = pk2(o[0], o[1]); w.y = pk2(o[2], o[3]); *(u32x2*)(orow + 16 * db) = w; }
    if (fq == 0) LSE[((size_t)pat * TOK + t) * 8 + h] = mx + logf(l);
}

__device__ __forceinline__ void combine_rows(const bf16* OP, const float* LSE, const float* gb, bf16* MIXED, int gw, int NGW, int lane) {
    const f32x4 g0 = *(const f32x4*)(gb + 8 * lane), g1 = *(const f32x4*)(gb + 8 * lane + 4);
    for (int t = gw; t < TOK; t += NGW) {
        const int h = lane >> 3; float ls[3]; u32x4 raw[3];
#pragma unroll
        for (int p = 0; p < 3; ++p) { ls[p] = LSE[((size_t)p * TOK + t) * 8 + h]; raw[p] = *(const u32x4*)(OP + ((size_t)p * TOK + t) * AW + 8 * lane); }
        const float mx = fmaxf(ls[0], fmaxf(ls[1], ls[2]));
        float a[3]; float sum = 0.f;
#pragma unroll
        for (int p = 0; p < 3; ++p) { a[p] = __expf(ls[p] - mx); sum += a[p]; }
        const float inv = 1.0f / sum; float o[8];
#pragma unroll
        for (int e = 0; e < 8; ++e) o[e] = 0.f;
#pragma unroll
        for (int p = 0; p < 3; ++p) { const float w = a[p] * inv;
            o[0] += w * bflo(raw[p].x); o[1] += w * bfhi(raw[p].x); o[2] += w * bflo(raw[p].y); o[3] += w * bfhi(raw[p].y);
            o[4] += w * bflo(raw[p].z); o[5] += w * bfhi(raw[p].z); o[6] += w * bflo(raw[p].w); o[7] += w * bfhi(raw[p].w); }
        float ss = 0.f;
#pragma unroll
        for (int e = 0; e < 8; ++e) ss += o[e] * o[e];
        const float rs = 1.0f / sqrtf(wave_sum(ss, lane) * (1.0f / AW) + EPS);
        u32x4 w; w.x = pk2(o[0] * rs * g0[0], o[1] * rs * g0[1]); w.y = pk2(o[2] * rs * g0[2], o[3] * rs * g0[3]); w.z = pk2(o[4] * rs * g1[0], o[5] * rs * g1[1]); w.w = pk2(o[6] * rs * g1[2], o[7] * rs * g1[3]);
        *(u32x4*)(MIXED + (size_t)t * DM + 512 + 8 * lane) = w;
    }
}

__device__ __forceinline__ void residual_rows(const bf16* Y, const float* xin, float* xout, const float* g_post, const float* g_next, bf16* HB, int gw, int NGW, int lane) {
    for (int t = gw; t < TOK; t += NGW) {
        const u32x2* yr = (const u32x2*)(Y + (size_t)t * DM) + lane; const f32x4* xr = (const f32x4*)(xin + (size_t)t * DM) + lane;
        f32x4 yv[4], xv[4]; float s = 0.f;
#pragma unroll
        for (int j = 0; j < 4; ++j) { const u32x2 w = yr[64 * j]; xv[j] = xr[64 * j]; yv[j][0] = bflo(w.x); yv[j][1] = bfhi(w.x); yv[j][2] = bflo(w.y); yv[j][3] = bfhi(w.y); s += dot4(yv[j]); }
        const float ry = 1.0f / sqrtf(wave_sum(s, lane) * (1.0f / DM) + EPS); float s2 = 0.f;
        f32x4* xo = (f32x4*)(xout + (size_t)t * DM) + lane;
#pragma unroll
        for (int j = 0; j < 4; ++j) { const f32x4 gp = ((const f32x4*)g_post)[lane + 64 * j]; xv[j] = xv[j] + yv[j] * ry * gp; s2 += dot4(xv[j]); xo[64 * j] = xv[j]; }
        if (g_next) { const float rx = 1.0f / sqrtf(wave_sum(s2, lane) * (1.0f / DM) + EPS); u32x2* ho = (u32x2*)(HB + (size_t)t * DM) + lane;
#pragma unroll
            for (int j = 0; j < 4; ++j) { const f32x4 gn = ((const f32x4*)g_next)[lane + 64 * j]; const f32x4 hv = xv[j] * rx * gn; u32x2 w; w.x = pk2(hv[0], hv[1]); w.y = pk2(hv[2], hv[3]); ho[64 * j] = w; } }
    }
}

constexpr int N_PHASES = 1 + 8 * NLAYER;
__global__ void __launch_bounds__(NTHR) fwd_megakernel(Args args) {
    extern __shared__ __attribute__((aligned(16))) unsigned char lds_raw[];
    LAS unsigned char* lds = (LAS unsigned char*)lds_raw;
    cg::grid_group grid = cg::this_grid();
    const int lo = args.ph_lo, hi = args.ph_hi;
    for (int ph = lo; ph < hi; ++ph) {
        int tid = threadIdx.x; asm volatile("" : "+v"(tid));
        int bx = blockIdx.x, G = gridDim.x; asm volatile("" : "+s"(bx), "+s"(G));
        const int lane = tid & 63, wave = __builtin_amdgcn_readfirstlane(tid >> 6);
        const int gw = bx * NWAVES + wave, NGW = G * NWAVES;
        const KAS unsigned char* kp = (const KAS unsigned char*)__builtin_amdgcn_kernarg_segment_ptr();
        asm volatile("" : "+s"(kp));
#define ARG_IN(i) (*(const float* const KAS*)(kp + 8 * (i)))
        float* const a_out = *(float* const KAS*)(kp + 136);
        unsigned char* const ws = *(unsigned char* const KAS*)(kp + 144);
        bf16* HB = (bf16*)(ws + WS_HB); bf16* PROJ = (bf16*)(ws + WS_PROJ); bf16* OPb = (bf16*)(ws + WS_OP); bf16* MIXED = (bf16*)(ws + WS_MIXED);
        bf16* Y1 = (bf16*)(ws + WS_Y1); bf16* Y2 = (bf16*)(ws + WS_Y2); bf16* HID = (bf16*)(ws + WS_HID); float* LSE = (float*)(ws + WS_LSE);
        const float* rope = (const float*)(ws + WS_ROPE);
        if (ph == 0) { prologue(ARG_IN(0), ARG_IN(1), ARG_IN(2), ARG_IN(9), ARG_IN(12), ARG_IN(15), ws, lds, gw, NGW, wave, lane); }
        else {
            const int l = (ph - 1) >> 3, k = (ph - 1) & 7;
            if (k == 0 || k == 3 || k == 5 || k == 6) {
                pg8::Gemm g; pg8::AnyOrder S; pg8::EpiAny E; E.bnd = (LAS float*)(lds + BND_OFF); E.a0 = nullptr; E.a1 = nullptr;
                S.mode = 0; S.uo.G = G; S.uo.c = bx;
                if (k == 0) {
                    g = pg8::Gemm{HB, (const bf16*)(ws + WS_WIN) + (size_t)l * INC * DM, TOK, INC, DM}; S.so.init(TOK, INC, G, bx); E.kind = 0; E.O = PROJ; E.a0 = rope;
                } else if (k == 3) {
                    g = pg8::Gemm{MIXED, (const bf16*)(ws + WS_WOUT) + (size_t)l * DM * DM, TOK, DM, DM}; S.so.init(TOK, DM, G, bx); E.kind = 1; E.O = Y1;
                } else if (k == 5) {
                    g = pg8::Gemm{HB, (const bf16*)(ws + WS_WUP) + (size_t)l * 2 * DFF * DM, TOK, 2 * DFF, DM}; S.so.init(TOK, 2 * DFF, G, bx); S.mode = 1; E.kind = 2; E.O = HID;
                    E.a0 = ARG_IN(13) + (size_t)l * 3 * 2 * DFF; E.a1 = ARG_IN(14) + (size_t)l * 2 * DFF;
                } else {
                    g = pg8::Gemm{HID, (const bf16*)(ws + WS_WDN) + (size_t)l * DM * DFF, TOK, DM, DFF}; S.so.init(TOK, DM, G, bx); E.kind = 1; E.O = Y2;
                }
                pg8::gemm_phase<pg8::EpiAny, pg8::AnyOrder, true, true>(lds, g, S, E, tid);
            } else if (k == 1) {
                for (int c = bx; c < TOK / 128; c += G)
                    mixA_chunk(lds, c, PROJ, ARG_IN(3) + l * AW, ARG_IN(4) + l * AW, ARG_IN(5) + (size_t)l * 4 * 128 * 128, ARG_IN(6) + l * 4 * 128, ARG_IN(7) + l * AW, MIXED, tid, wave, lane);
                constexpr int NITEM = BATCH * 8 * 96; const int per = (NITEM + G - 1) / G;
                for (int it = bx * per; it < (bx + 1) * per && it < NITEM; ++it) attn_item(lds, it, PROJ, OPb, LSE, tid, wave, lane);
            } else if (k == 2) {
                combine_rows(OPb, LSE, ARG_IN(8) + l * AW, MIXED, gw, NGW, lane);
            } else {
                const bool a = (k == 4);
                const float* xin = (a && l == 0) ? ARG_IN(0) : a_out;
                const float* gpost = (a ? ARG_IN(10) : ARG_IN(16)) + l * DM;
                const float* gnext = a ? ARG_IN(11) + l * DM : ((l + 1 < NLAYER) ? ARG_IN(1) + (l + 1) * DM : nullptr);
                residual_rows(a ? Y1 : Y2, xin, a_out, gpost, gnext, HB, gw, NGW, lane);
            }
        }
        if (ph + 1 < hi) grid.sync();
    }
}

extern "C" void kernel_launch(void* const* d_in, const int* in_sizes, int n_in, void* d_out, int out_size, void* d_ws, size_t ws_size, hipStream_t stream) {
    static int grid = 0;
    if (grid == 0) {
        int dev = 0, cus = 0, per_cu = 0;
        if (n_in != 17 || out_size != TOK * DM || ws_size < WS_END) { fprintf(stderr, "kernel_launch: unexpected shapes (n_in %d, out %d, ws %zu)\n", n_in, out_size, ws_size); grid = -1; return; }
        hipGetDevice(&dev); hipDeviceGetAttribute(&cus, hipDeviceAttributeMultiprocessorCount, dev);
        if (hipFuncSetAttribute((const void*)fwd_megakernel, hipFuncAttributeMaxDynamicSharedMemorySize, LDS_BYTES) != hipSuccess) { fprintf(stderr, "kernel_launch: hipFuncSetAttribute failed\n"); grid = -1; return; }
        if (hipOccupancyMaxActiveBlocksPerMultiprocessor(&per_cu, (const void*)fwd_megakernel, NTHR, LDS_BYTES) != hipSuccess || per_cu < 1) { fprintf(stderr, "kernel_launch: occupancy query says %d\n", per_cu); per_cu = 1; }
        (void)hipGetLastError();
        grid = cus * per_cu;
        fprintf(stderr, "kernel_launch: grid %d (cus %d x %d)\n", grid, cus, per_cu);
    }
    if (grid < 0) return;
    Args a{};
    for (int i = 0; i < 17; ++i) a.in[i] = (const float*)d_in[i];
    a.out = (float*)d_out; a.ws = (unsigned char*)d_ws; a.ph_lo = 0; a.ph_hi = N_PHASES;
    void* kargs[] = {&a};
    hipError_t e = hipLaunchCooperativeKernel((const void*)fwd_megakernel, dim3(grid), dim3(NTHR), kargs, LDS_BYTES, stream);
    if (e != hipSuccess) fprintf(stderr, "kernel_launch: cooperative launch failed: %s (grid %d)\n", hipGetErrorString(e), grid);
}
```

```cpp
#include <hip/hip_runtime.h>
#include <hip/hip_cooperative_groups.h>
#include <cstdio>
#include <cstdint>
namespace cg = cooperative_groups;
#ifndef PROBE_DBL
#define PROBE_DBL 0
#endif
namespace pg8 {
#define PG8_LAS __attribute__((address_space(3)))
typedef unsigned short bf16_t;
typedef short bf16x8 __attribute__((ext_vector_type(8)));
typedef float f32x4 __attribute__((ext_vector_type(4)));
typedef unsigned u32x4 __attribute__((ext_vector_type(4)));
constexpr int BM = 256, BK = 64, HALF = 128, HTB = HALF * BK * 2  , STAGE_BYTES = 8 * HTB, NXCD = 8, WGM = 8;

__host__ __device__ __forceinline__ int lds_byte(int r, int c) { const int st = (r >> 4) * 2 + (c >> 5), rr = r & 15, cc = c & 31, ob = rr * 64 + cc * 2; return st * 1024 + (ob ^ (((ob >> 9) & 1) << 5)); }
__host__ __device__ __forceinline__ void stage_rc(int b, int& R, int& C) { const int st = b / 1024, sb = b % 1024, swz = sb ^ (((sb >> 9) & 1) << 5); R = (st >> 1) * 16 + swz / 64; C = (st & 1) * 32 + (swz % 64) / 2; }
__host__ __device__ __forceinline__ int perm32(int rho) { const int n = rho >> 4, i = rho & 15; return 8 * (i >> 2) + 4 * n + (i & 3); }

struct Unit { int pm, pn; };
struct Gemm { const bf16_t* A; const bf16_t* Bt; int M, N, K; };

struct StaticOrder {
    int nM, nN, nwg, G, c;
    __host__ __device__ void init(int M, int N, int G_, int c_) { nM = M / BM; nN = N / BM; nwg = nM * nN; G = G_; c = c_; }
    __host__ __device__ bool next(int i, Unit& u) const {
        const long L = (long)i * G + c; if (L >= nwg) return false;
        int wgid = (int)L; { const int q = nwg / NXCD, r = nwg % NXCD, xcd = wgid % NXCD, off = wgid / NXCD; wgid = (xcd < r ? xcd * (q + 1) : r * (q + 1) + (xcd - r) * q) + off; }
        const int nig = WGM * nN, gid = wgid / nig, fm = gid * WGM, gsz = (nM - fm) < WGM ? (nM - fm) : WGM;
        u.pm = fm + ((wgid % nig) % gsz); u.pn = (wgid % nig) / gsz; return true;
    }
    __device__ __forceinline__ void a_ready(const Unit&) const {}
    __device__ __forceinline__ void done(const Unit&) const {}
};

__device__ __forceinline__ unsigned cvt_pk_bf16(float lo, float hi) { unsigned r; asm volatile("v_cvt_pk_bf16_f32 %0, %1, %2" : "=v"(r) : "v"(lo), "v"(hi)); return r; }
typedef float f32x2 __attribute__((ext_vector_type(2)));
__device__ __forceinline__ f32x2 gelu_pk(f32x2 v) {
    const f32x2 av = __builtin_elementwise_abs(v), d = av * 0.2316418882f + 1.0f;
    f32x2 t; t.x = __builtin_amdgcn_rcpf(d.x); t.y = __builtin_amdgcn_rcpf(d.y);
    f32x2 q = t * 0.5307027145f + (-0.7265760135f); q = q * t + 0.7107068705f; q = q * t + (-0.142248368f); q = q * t + 0.127414796f; q = q * t;
    const f32x2 s = (v * v) * (-0.72134752044f);
    f32x2 e; e.x = __builtin_amdgcn_exp2f(s.x); e.y = __builtin_amdgcn_exp2f(s.y);
    const f32x2 m = v * (q * e), r = v - m;
    f32x2 o; o.x = v.x < 0.f ? m.x : r.x; o.y = v.y < 0.f ? m.y : r.y; return o;
}

template <int ACT  > struct EpiBf16 {
    static constexpr bool PERM = true, AFTER_DRAIN = false; static_assert(ACT == 0 || ACT == 1, "EpiBf16: ACT is 0 (none) or 1 (gelu_pk)");
    bf16_t* O; int ldc; const float* bias; int split_cols; size_t split_stride; float scale0;
    __device__ __forceinline__ void operator()(const f32x4 (&acc)[2][2][4][2], const Unit& u, int wr, int wc, int fr, int fq) const {
        const int row0 = u.pm * BM + wr * 64 + fr; int colt = u.pn * BM; bf16_t* base = O;
        float sc = 1.f; if (split_cols) { const int t = colt / split_cols; base += (size_t)t * split_stride; colt -= t * split_cols; if (t == 0) sc = scale0; }
        const int col0 = colt + wc * 32 + 8 * fq, bcol0 = u.pn * BM + wc * 32 + 8 * fq;
        f32x4 bv[2][2];
#pragma unroll
        for (int bj = 0; bj < 2; ++bj)
#pragma unroll
            for (int n = 0; n < 2; ++n) bv[bj][n] = bias ? *(const f32x4*)(bias + bcol0 + bj * HALF + 4 * n) : (f32x4){0.f, 0.f, 0.f, 0.f};
#pragma unroll
        for (int ai = 0; ai < 2; ++ai)
#pragma unroll
            for (int m = 0; m < 4; ++m) { bf16_t* rowp = base + (size_t)(row0 + ai * HALF + m * 16) * ldc + col0;
#pragma unroll
                for (int bj = 0; bj < 2; ++bj) { f32x4 v0 = acc[ai][bj][m][0] + bv[bj][0], v1 = acc[ai][bj][m][1] + bv[bj][1];
                    if (ACT == 1) { f32x2 a = gelu_pk((f32x2){v0[0], v0[1]}), b = gelu_pk((f32x2){v0[2], v0[3]}), c = gelu_pk((f32x2){v1[0], v1[1]}), d = gelu_pk((f32x2){v1[2], v1[3]});
                        v0 = (f32x4){a.x, a.y, b.x, b.y}; v1 = (f32x4){c.x, c.y, d.x, d.y}; }
                    v0 = v0 * sc; v1 = v1 * sc; u32x4 w; w.x = cvt_pk_bf16(v0[0], v0[1]); w.y = cvt_pk_bf16(v0[2], v0[3]); w.z = cvt_pk_bf16(v1[0], v1[1]); w.w = cvt_pk_bf16(v1[2], v1[3]);
                    *(u32x4*)(rowp + bj * HALF) = w; } }
    }
};

__device__ __forceinline__ float shx(float v, int m, int lane) { return __builtin_bit_cast(float, __builtin_amdgcn_ds_bpermute((lane ^ m) << 2, __builtin_bit_cast(int, v))); }
__device__ __forceinline__ float gelu_tanh_f(float x) {
    const float u = 0.7978845608028654f * (x + 0.044715f * x * x * x);
    const float e = __builtin_amdgcn_exp2f(-2.8853900817779268f * u);
    return x * __builtin_amdgcn_rcpf(1.0f + e);
}
struct EpiProj {
    static constexpr bool PERM = true, AFTER_DRAIN = false;
    bf16_t* O; const float* rope;
    __device__ __forceinline__ void operator()(const f32x4 (&acc)[2][2][4][2], const Unit& u, int wr, int wc, int fr, int fq) const {
        const int row0 = u.pm * BM + wr * 64 + fr; const int col0 = u.pn * BM + wc * 32 + 8 * fq;
        const int kind = u.pn < 4 ? 0 : (u.pn < 8 ? 1 : 2);
        const float qs = (u.pn < 6) ? 0.125f : 1.0f;
        const bool ropelane = ((wc & 1) == 0) && (fq < 2);
        const float sgn = (fq == 0) ? -1.0f : 1.0f;
#pragma unroll
        for (int ai = 0; ai < 2; ++ai)
#pragma unroll
            for (int m = 0; m < 4; ++m) {
                const int row = row0 + ai * HALF + m * 16;
                bf16_t* rowp = O + (size_t)row * 2560 + col0;
                f32x4 c0 = {1.f, 1.f, 1.f, 1.f}, c1 = c0, s0 = {0.f, 0.f, 0.f, 0.f}, s1 = s0;
                if (kind == 1 && ropelane) { const float* rp = rope + (size_t)(row & 4095) * 16;
                    c0 = *(const f32x4*)(rp); c1 = *(const f32x4*)(rp + 4); s0 = *(const f32x4*)(rp + 8); s1 = *(const f32x4*)(rp + 12); s0 = s0 * sgn; s1 = s1 * sgn; }
#pragma unroll
                for (int bj = 0; bj < 2; ++bj) {
                    f32x4 v0 = acc[ai][bj][m][0], v1 = acc[ai][bj][m][1];
                    if (kind == 0) {
                        f32x2 a = gelu_pk((f32x2){v0[0], v0[1]}), b = gelu_pk((f32x2){v0[2], v0[3]}), c = gelu_pk((f32x2){v1[0], v1[1]}), d = gelu_pk((f32x2){v1[2], v1[3]});
                        v0 = (f32x4){a.x, a.y, b.x, b.y}; v1 = (f32x4){c.x, c.y, d.x, d.y};
                    } else if (kind == 1) {
                        f32x4 p0, p1;
#pragma unroll
                        for (int e = 0; e < 4; ++e) { p0[e] = shx(v0[e], 16, fq * 16 + fr); p1[e] = shx(v1[e], 16, fq * 16 + fr); }
                        v0 = (v0 * c0 + p0 * s0) * qs; v1 = (v1 * c1 + p1 * s1) * qs;
                    }
                    u32x4 w; w.x = cvt_pk_bf16(v0[0], v0[1]); w.y = cvt_pk_bf16(v0[2], v0[3]); w.z = cvt_pk_bf16(v1[0], v1[1]); w.w = cvt_pk_bf16(v1[2], v1[3]);
                    *(u32x4*)(rowp + bj * HALF) = w;
                }
                asm volatile("" ::: "memory");
            }
    }
};
__device__ __forceinline__ float dpp_ror1(float v) { return __builtin_bit_cast(float, __builtin_amdgcn_update_dpp(0, __builtin_bit_cast(int, v), 0x121, 0xf, 0xf, false)); }
__device__ __forceinline__ float dpp_ror2(float v) { return __builtin_bit_cast(float, __builtin_amdgcn_update_dpp(0, __builtin_bit_cast(int, v), 0x122, 0xf, 0xf, false)); }
struct EpiUp {
    static constexpr bool PERM = true, AFTER_DRAIN = false;
    bf16_t* H; const float* cw; const float* cb; PG8_LAS float* bnd;
    __device__ __forceinline__ void operator()(const f32x4 (&acc)[2][2][4][2], const Unit& u, int wr, int wc, int fr, int fq) const {
        const int par = u.pm & 1;
        PG8_LAS float* bw = bnd + par * 2048; PG8_LAS float* bo = bnd + (par ^ 1) * 2048;
        const int lc = wc * 32 + 8 * fq;
        if (fr >= 14) {
#pragma unroll
            for (int ai = 0; ai < 2; ++ai)
#pragma unroll
                for (int bj = 0; bj < 2; ++bj)
#pragma unroll
                    for (int n = 0; n < 2; ++n) *(PG8_LAS f32x4*)(bw + ((2 * ai + wr) * 2 + (fr - 14)) * 256 + bj * HALF + lc + 4 * n) = acc[ai][bj][3][n];
        }
        asm volatile("s_waitcnt lgkmcnt(0)" ::: "memory"); __builtin_amdgcn_s_barrier(); asm volatile("" ::: "memory");
        const bool first = (u.pm & 15) == 0;
        const int prow = fr >= 14 ? fr - 14 : 0;
        typedef float f32x2v __attribute__((ext_vector_type(2)));
#pragma unroll
        for (int n = 0; n < 2; ++n)
#pragma unroll
        for (int jp = 0; jp < 2; ++jp) {
            const int f0 = u.pn * HALF + lc + 4 * n + 2 * jp;
            const f32x2v wg0 = *(const f32x2v*)(cw + f0), wg1 = *(const f32x2v*)(cw + 8192 + f0), wg2 = *(const f32x2v*)(cw + 16384 + f0), bg = *(const f32x2v*)(cb + f0);
            const f32x2v wv0 = *(const f32x2v*)(cw + 4096 + f0), wv1 = *(const f32x2v*)(cw + 8192 + 4096 + f0), wv2 = *(const f32x2v*)(cw + 16384 + 4096 + f0), bv = *(const f32x2v*)(cb + 4096 + f0);
#pragma unroll
            for (int ai = 0; ai < 2; ++ai) {
                const int g = 2 * ai + wr;
                f32x2v pg = {0.f, 0.f}, pv = pg;
                if (g == 0) { if (!first) { pg = *(PG8_LAS f32x2v*)(bo + (3 * 2 + prow) * 256 + lc + 4 * n + 2 * jp); pv = *(PG8_LAS f32x2v*)(bo + (3 * 2 + prow) * 256 + HALF + lc + 4 * n + 2 * jp); } }
                else { pg = *(PG8_LAS f32x2v*)(bw + ((g - 1) * 2 + prow) * 256 + lc + 4 * n + 2 * jp); pv = *(PG8_LAS f32x2v*)(bw + ((g - 1) * 2 + prow) * 256 + HALF + lc + 4 * n + 2 * jp); }
#pragma unroll
                for (int m = 0; m < 4; ++m) {
                    float y[2];
#pragma unroll
                    for (int jj = 0; jj < 2; ++jj) {
                        const int j = 2 * jp + jj;
                        const float a = acc[ai][0][m][n][j], b = acc[ai][1][m][n][j];
                        const float qa = (m == 0) ? pg[jj] : acc[ai][0][m == 0 ? 0 : m - 1][n][j], qb = (m == 0) ? pv[jj] : acc[ai][1][m == 0 ? 0 : m - 1][n][j];
                        const float a1c = dpp_ror1(a), a2c = dpp_ror2(a), a1p = dpp_ror1(qa), a2p = dpp_ror2(qa);
                        const float b1c = dpp_ror1(b), b2c = dpp_ror2(b), b1p = dpp_ror1(qb), b2p = dpp_ror2(qb);
                        const float a1 = (fr == 0) ? a1p : a1c, a2 = (fr < 2) ? a2p : a2c;
                        const float b1 = (fr == 0) ? b1p : b1c, b2 = (fr < 2) ? b2p : b2c;
                        const float gcv = bg[jj] + wg0[jj] * a2 + wg1[jj] * a1 + wg2[jj] * a;
                        const float vcv = bv[jj] + wv0[jj] * b2 + wv1[jj] * b1 + wv2[jj] * b;
                        y[jj] = gelu_tanh_f(gcv) * vcv;
                    }
                    const int row = u.pm * BM + ai * HALF + wr * 64 + m * 16 + fr;
                    *(unsigned*)(H + (size_t)row * 4096 + f0) = cvt_pk_bf16(y[0], y[1]);
                }
            }
            asm volatile("" ::: "memory");
        }
    }
};
struct UpOrder {
    int G, c;
    __device__ bool next(int i, Unit& u) const {
        const int run = c + (i >> 4) * G; if (run >= 256) return false;
        const int xcd = run & 7, idx = run >> 3;
        u.pn = xcd * 4 + (idx & 3); u.pm = (idx >> 2) * 16 + (i & 15); return true;
    }
    __device__ __forceinline__ void a_ready(const Unit&) const {}
    __device__ __forceinline__ void done(const Unit&) const {}
};


struct EpiAny {
    static constexpr bool PERM = true, AFTER_DRAIN = false;
    int kind; bf16_t* O; const float* a0; const float* a1; PG8_LAS float* bnd;
    __device__ __forceinline__ void operator()(const f32x4 (&acc)[2][2][4][2], const Unit& u, int wr, int wc, int fr, int fq) const {
        if (kind == 0) { const EpiProj e{O, a0}; e(acc, u, wr, wc, fr, fq); }
        else if (kind == 1) { const EpiBf16<0> e{O, 1024, nullptr, 0, 0, 1.f}; e(acc, u, wr, wc, fr, fq); }
        else { const EpiUp e{O, a0, a1, bnd}; e(acc, u, wr, wc, fr, fq); }
    }
};
struct AnyOrder {
    int mode; StaticOrder so; UpOrder uo;
    __device__ __forceinline__ bool next(int i, Unit& u) const { return mode ? uo.next(i, u) : so.next(i, u); }
    __device__ __forceinline__ void a_ready(const Unit&) const {}
    __device__ __forceinline__ void done(const Unit&) const {}
};
template <class Epi, class Sched, bool ALIGN_EPI = false, bool SP2 = false>
__device__ __forceinline__ void gemm_phase(PG8_LAS unsigned char* lds, const Gemm g, const Sched& S, const Epi& E, const int tid) {
    const int wid = __builtin_amdgcn_readfirstlane(tid >> 6), lane = tid & 63, wr = wid >> 2, wc = wid & 3, fr = lane & 15, fq = lane >> 4;
    const int K = g.K, nt = K / BK;
    unsigned voffA[2], voffB[2];
#pragma unroll
    for (int i = 0; i < 2; ++i) { int R, C; stage_rc(tid * 16 + i * 8192, R, C); const int Rb = Epi::PERM ? ((R & ~31) + perm32(R & 31)) : R;
        voffA[i] = (unsigned)(R * K + C) * 2u; voffB[i] = (unsigned)(Rb * K + C) * 2u; }
    const size_t kstep = (size_t)(BK * 2);
    const size_t hstep = (size_t)HALF * K * 2;
    const size_t tstep = 2 * hstep;
    const unsigned ldsw = (unsigned)wid * 1024u;
    const int aoff = lds_byte(wr * 64 + fr, fq * 8), boff = lds_byte(wc * 32 + fr, fq * 8);
#define PG8_SA(b, h) (((b) * 2 + (h)) * HTB)
#define PG8_SB(b, h) ((4 + (b) * 2 + (h)) * HTB)
#define PG8_STAGE(bufoff, gbase, voff) do { _Pragma("unroll") for (int _i = 0; _i < 2; ++_i) \
        __builtin_amdgcn_global_load_lds((const unsigned*)((const char*)(gbase) + (voff)[_i]), (PG8_LAS unsigned*)(lds + (bufoff) + ldsw + _i * 8192), 16, 0, 0); } while (0)
#define PG8_LDA(dst, b, h) do { _Pragma("unroll") for (int m = 0; m < 4; ++m) _Pragma("unroll") for (int k = 0; k < 2; ++k) dst[m][k] = *(const PG8_LAS bf16x8*)(lds + PG8_SA(b, h) + aoff + m * 2048 + k * 1024); } while (0)
#define PG8_LDB(dst, b, h) do { _Pragma("unroll") for (int n = 0; n < 2; ++n) _Pragma("unroll") for (int k = 0; k < 2; ++k) dst[n][k] = *(const PG8_LAS bf16x8*)(lds + PG8_SB(b, h) + boff + n * 2048 + k * 1024); } while (0)
#define PG8_MMA(ai, bj, At, Bt) do { __builtin_amdgcn_s_setprio(1); _Pragma("unroll") for (int m = 0; m < 4; ++m) _Pragma("unroll") for (int n = 0; n < 2; ++n) _Pragma("unroll") for (int k = 0; k < 2; ++k) \
        acc[ai][bj][m][n] = __builtin_amdgcn_mfma_f32_16x16x32_bf16(Bt[n][k], At[m][k], acc[ai][bj][m][n], 0, 0, 0); __builtin_amdgcn_s_setprio(0); } while (0)
#define PG8_WAIT_V(n) asm volatile("s_waitcnt vmcnt(" #n ")" ::: "memory")
#define PG8_WAIT_L(n) asm volatile("s_waitcnt lgkmcnt(" #n ")" ::: "memory")
#define PG8_BAR __builtin_amdgcn_s_barrier()
#define PG8_SCHED __builtin_amdgcn_sched_barrier(0)
    Unit cur, nxt; int ui = 0;
    if (!S.next(0, cur)) return;
    f32x4 acc[2][2][4][2];
#pragma unroll
    for (int a = 0; a < 2; ++a)
#pragma unroll
        for (int b = 0; b < 2; ++b)
#pragma unroll
            for (int m = 0; m < 4; ++m)
#pragma unroll
                for (int n = 0; n < 2; ++n) acc[a][b][m][n] = (f32x4){0.f, 0.f, 0.f, 0.f};
    bf16x8 At[4][2], B0[2][2], B1[2][2];
    const char* cA = (const char*)g.A + (size_t)cur.pm * tstep; const char* cB = (const char*)g.Bt + (size_t)cur.pn * tstep;
    S.a_ready(cur);
    if constexpr (SP2) {
        PG8_STAGE(PG8_SB(0, 0), cB, voffB); PG8_STAGE(PG8_SB(0, 1), cB + hstep, voffB); PG8_STAGE(PG8_SA(0, 0), cA, voffA); PG8_STAGE(PG8_SA(0, 1), cA + hstep, voffA);
        if (wr == 1) PG8_BAR;
        PG8_WAIT_V(2); PG8_BAR;
        PG8_STAGE(PG8_SB(1, 0), cB + kstep, voffB); PG8_STAGE(PG8_SA(1, 0), cA + kstep, voffA); PG8_STAGE(PG8_SB(1, 1), cB + hstep + kstep, voffB);
        PG8_WAIT_V(6); PG8_BAR;
    } else {
        PG8_STAGE(PG8_SB(0, 0), cB, voffB); PG8_STAGE(PG8_SA(0, 0), cA, voffA); PG8_STAGE(PG8_SB(0, 1), cB + hstep, voffB); PG8_STAGE(PG8_SA(0, 1), cA + hstep, voffA);
        if (wr == 1) PG8_BAR;
        PG8_WAIT_V(4); PG8_BAR;
        PG8_STAGE(PG8_SB(1, 0), cB + kstep, voffB); PG8_STAGE(PG8_SA(1, 0), cA + kstep, voffA); PG8_STAGE(PG8_SB(1, 1), cB + hstep + kstep, voffB);
        PG8_WAIT_V(6); PG8_BAR;
    }
    for (;;) {
        const bool has_next = S.next(ui + 1, nxt);
        const char* nA = has_next ? (const char*)g.A + (size_t)nxt.pm * tstep : cA; const char* nB = has_next ? (const char*)g.Bt + (size_t)nxt.pn * tstep : cB;
        for (int t = 0; t < nt; t += 2) {
            const bool last = (t == nt - 2);
            const char* a1 = cA + (size_t)(t + 1) * kstep;
            const char* a2 = last ? nA : cA + (size_t)(t + 2) * kstep; const char* b2 = last ? nB : cB + (size_t)(t + 2) * kstep;
            const char* a3 = a2 + kstep; const char* b3 = b2 + kstep;
            if (last && has_next) S.a_ready(nxt);
            if constexpr (SP2) {
            PG8_LDB(B0, 0, 0); PG8_LDB(B1, 0, 1); PG8_SCHED; PG8_LDA(At, 0, 0); PG8_STAGE(PG8_SA(1, 1), a1 + hstep, voffA);
            PG8_WAIT_V(8); PG8_WAIT_L(0); PG8_BAR; PG8_MMA(0, 0, At, B0); PG8_MMA(0, 1, At, B1); PG8_BAR; PG8_SCHED;
            PG8_LDA(At, 0, 1); PG8_STAGE(PG8_SB(0, 0), b2, voffB); PG8_STAGE(PG8_SB(0, 1), b2 + hstep, voffB); PG8_STAGE(PG8_SA(0, 0), a2, voffA);
            PG8_WAIT_V(8); PG8_WAIT_L(0); PG8_BAR; PG8_MMA(1, 0, At, B0); PG8_MMA(1, 1, At, B1); PG8_BAR; PG8_SCHED;
            PG8_LDB(B0, 1, 0); PG8_LDB(B1, 1, 1); PG8_SCHED; PG8_LDA(At, 1, 0); PG8_STAGE(PG8_SA(0, 1), a2 + hstep, voffA);
            PG8_WAIT_V(8); PG8_WAIT_L(0); PG8_BAR; PG8_MMA(0, 0, At, B0); PG8_MMA(0, 1, At, B1); PG8_BAR; PG8_SCHED;
            PG8_LDA(At, 1, 1); PG8_STAGE(PG8_SB(1, 0), b3, voffB); PG8_STAGE(PG8_SB(1, 1), b3 + hstep, voffB); PG8_STAGE(PG8_SA(1, 0), a3, voffA);
            PG8_WAIT_V(8); PG8_WAIT_L(0); PG8_BAR; PG8_MMA(1, 0, At, B0); PG8_MMA(1, 1, At, B1); PG8_BAR; PG8_SCHED;
            } else {
            PG8_LDB(B0, 0, 0); PG8_SCHED; PG8_LDA(At, 0, 0); PG8_STAGE(PG8_SA(1, 1), a1 + hstep, voffA);
            PG8_WAIT_L(8); PG8_BAR; PG8_WAIT_L(0); PG8_MMA(0, 0, At, B0); PG8_BAR; PG8_SCHED;
            PG8_LDB(B1, 0, 1); PG8_STAGE(PG8_SB(0, 0), b2, voffB);
            PG8_BAR; PG8_WAIT_L(0); PG8_MMA(0, 1, At, B1); PG8_BAR;
            PG8_LDA(At, 0, 1); PG8_STAGE(PG8_SA(0, 0), a2, voffA);
            PG8_BAR; PG8_WAIT_L(0); PG8_MMA(1, 0, At, B0); PG8_BAR; PG8_SCHED;
            PG8_STAGE(PG8_SB(0, 1), b2 + hstep, voffB);
            PG8_WAIT_V(6); PG8_BAR; PG8_MMA(1, 1, At, B1); PG8_BAR;
            PG8_LDB(B0, 1, 0); PG8_SCHED; PG8_LDA(At, 1, 0); PG8_STAGE(PG8_SA(0, 1), a2 + hstep, voffA);
            PG8_WAIT_L(8); PG8_BAR; PG8_WAIT_L(0); PG8_MMA(0, 0, At, B0); PG8_BAR; PG8_SCHED;
            PG8_LDB(B1, 1, 1); PG8_STAGE(PG8_SB(1, 0), b3, voffB);
            PG8_BAR; PG8_WAIT_L(0); PG8_MMA(0, 1, At, B1); PG8_BAR;
            PG8_LDA(At, 1, 1); PG8_STAGE(PG8_SA(1, 0), a3, voffA);
            PG8_BAR; PG8_WAIT_L(0); PG8_MMA(1, 0, At, B0); PG8_BAR; PG8_SCHED;
            PG8_STAGE(PG8_SB(1, 1), b3 + hstep, voffB);
            PG8_WAIT_V(6); PG8_BAR; PG8_MMA(1, 1, At, B1); PG8_BAR;
            }
        }
        if constexpr (ALIGN_EPI) { if (wr == 0) PG8_BAR; }
        if constexpr (!Epi::AFTER_DRAIN) { E(acc, cur, wr, wc, fr, fq); S.done(cur); }
        if (!has_next) break;
#pragma unroll
        for (int a = 0; a < 2; ++a)
#pragma unroll
            for (int b = 0; b < 2; ++b)
#pragma unroll
                for (int m = 0; m < 4; ++m)
#pragma unroll
                    for (int n = 0; n < 2; ++n) acc[a][b][m][n] = (f32x4){0.f, 0.f, 0.f, 0.f};
        cur = nxt; cA = nA; cB = nB; ++ui;
        if constexpr (ALIGN_EPI) { if (wr == 1) PG8_BAR; }
    }
    PG8_WAIT_V(0);
    if constexpr (!ALIGN_EPI) { if (wr == 0) PG8_BAR; }
    PG8_BAR;
    if constexpr (Epi::AFTER_DRAIN) { E.fused(acc, cur, wr, wc, fr, fq, lds, wid, lane); S.done(cur); }
#undef PG8_SA
#undef PG8_SB
#undef PG8_STAGE
#undef PG8_LDA
#undef PG8_LDB
#undef PG8_MMA
#undef PG8_WAIT_V
#undef PG8_WAIT_L
#undef PG8_BAR
#undef PG8_SCHED
}
}

constexpr int NWAVES = 8, NTHR = NWAVES * 64;
constexpr int BATCH = 8, SEQ = 4096, DM = 1024, TOK = BATCH * SEQ, INC = 2560, AW = 512, DFF = 4096, NLAYER = 2;
constexpr float EPS = 1e-6f;
constexpr size_t MiB = 1u << 20;
constexpr size_t WS_WIN = 1 * MiB, WS_WOUT = 11 * MiB, WS_WUP = 15 * MiB, WS_WDN = 47 * MiB, WS_ROPE = 63 * MiB;
constexpr size_t WS_HB = 64 * MiB;
constexpr size_t WS_HID = 128 * MiB;
constexpr size_t WS_PROJ = 128 * MiB;
constexpr size_t WS_OP = 288 * MiB;
constexpr size_t WS_Y1 = 128 * MiB;
constexpr size_t WS_MIXED = 384 * MiB;
constexpr size_t WS_Y2 = 384 * MiB;
constexpr size_t WS_LSE = 448 * MiB;
constexpr size_t WS_END = 452 * MiB;
constexpr int LDS_BYTES = 147456 + 64;
constexpr int BND_OFF = 131072, MISC_OFF = 147456;

#define LAS __attribute__((address_space(3)))
#define KAS __attribute__((address_space(4)))
typedef unsigned short bf16;
typedef unsigned u32x4 __attribute__((ext_vector_type(4)));
typedef unsigned u32x2 __attribute__((ext_vector_type(2)));
typedef float f32x4 __attribute__((ext_vector_type(4)));
typedef short bf16x8 __attribute__((ext_vector_type(8)));
typedef short bf16x4 __attribute__((ext_vector_type(4)));

__device__ __forceinline__ float bflo(unsigned w) { return __builtin_bit_cast(float, w << 16); }
__device__ __forceinline__ float bfhi(unsigned w) { return __builtin_bit_cast(float, w & 0xffff0000u); }
__device__ __forceinline__ unsigned pk2(float lo, float hi) { return pg8::cvt_pk_bf16(lo, hi); }
__device__ __forceinline__ float wave_sum(float v, int lane) {
#pragma unroll
    for (int o = 1; o < 64; o <<= 1) v += pg8::shx(v, o, lane);
    return v;
}
__device__ __forceinline__ float dot4(f32x4 a) { return (a[0] * a[0] + a[1] * a[1]) + (a[2] * a[2] + a[3] * a[3]); }
#define WG_BARRIER() do { asm volatile("s_waitcnt vmcnt(0) lgkmcnt(0)" ::: "memory"); __builtin_amdgcn_s_barrier(); asm volatile("" ::: "memory"); } while (0)

__device__ __forceinline__ void transpose_item(const float* W, int K, int N, bf16* WT, int k0, int n0, int drow0, LAS float* scr, int lane) {
#pragma unroll 8
    for (int i = 0; i < 32; ++i) { const int kk = 2 * i + (lane >> 5); scr[kk * 33 + (lane & 31)] = W[(size_t)(k0 + kk) * N + n0 + (lane & 31)]; }
    asm volatile("s_waitcnt lgkmcnt(0)" ::: "memory");
    const int c = lane & 7;
#pragma unroll
    for (int j = 0; j < 4; ++j) { const int n = (lane >> 3) + 8 * j; const LAS float* s = scr + (8 * c) * 33 + n;
        u32x4 o; o.x = pk2(s[0 * 33], s[1 * 33]); o.y = pk2(s[2 * 33], s[3 * 33]); o.z = pk2(s[4 * 33], s[5 * 33]); o.w = pk2(s[6 * 33], s[7 * 33]);
        *(u32x4*)(WT + (size_t)(drow0 + n) * K + k0 + 8 * c) = o; }
    asm volatile("s_waitcnt lgkmcnt(0)" ::: "memory");
}
__device__ __forceinline__ void rms_row_to_bf16(const float* xrow, const float* g, bf16* orow, int lane) {
    const f32x4* xr = (const f32x4*)xrow + lane; const f32x4* gr = (const f32x4*)g + lane;
    f32x4 v[4]; float s = 0.f;
#pragma unroll
    for (int j = 0; j < 4; ++j) { v[j] = xr[64 * j]; s += dot4(v[j]); }
    const float rstd = 1.0f / sqrtf(wave_sum(s, lane) * (1.0f / DM) + EPS);
    u32x2* o8 = (u32x2*)orow + lane;
#pragma unroll
    for (int j = 0; j < 4; ++j) { const f32x4 gg = gr[64 * j]; const f32x4 y = v[j] * rstd * gg; u32x2 w; w.x = pk2(y[0], y[1]); w.y = pk2(y[2], y[3]); o8[64 * j] = w; }
}
struct Args { const float* in[17]; float* out; unsigned char* ws; int ph_lo, ph_hi; };
__device__ __forceinline__ void prologue(const float* x, const float* g0, const float* w_in, const float* w_out, const float* w_up, const float* w_dn, unsigned char* ws_, LAS unsigned char* lds, int gw, int NGW, int wave, int lane) {
    LAS float* scr = (LAS float*)(lds + wave * 16384);
    constexpr int I_IN = 16 * 80, I_OUT = 16 * 32, I_UP = 16 * 256, I_DN = 64 * 32, I_L = I_IN + I_OUT + I_UP + I_DN;
    for (int it = gw; it < NLAYER * I_L; it += NGW) {
        const int l = it / I_L; int r = it % I_L;
        if (r < I_IN) { const int nb = r % 80, kb = r / 80;
            transpose_item(w_in + (size_t)l * DM * INC, DM, INC, (bf16*)(ws_ + WS_WIN) + (size_t)l * INC * DM, 64 * kb, 32 * nb, 32 * nb, scr, lane); continue; }
        r -= I_IN;
        if (r < I_OUT) { const int nb = r % 32, kb = r / 32;
            transpose_item(w_out + (size_t)l * DM * DM, DM, DM, (bf16*)(ws_ + WS_WOUT) + (size_t)l * DM * DM, 64 * kb, 32 * nb, 32 * nb, scr, lane); continue; }
        r -= I_OUT;
        if (r < I_UP) { const int nb = r % 256, kb = r / 256; const int n0 = 32 * nb; const int f0 = n0 & 4095;
            const int drow0 = (f0 >> 7) * 256 + (n0 >= 4096 ? 128 : 0) + (f0 & 127);
            transpose_item(w_up + (size_t)l * DM * 2 * DFF, DM, 2 * DFF, (bf16*)(ws_ + WS_WUP) + (size_t)l * 2 * DFF * DM, 64 * kb, n0, drow0, scr, lane); continue; }
        r -= I_UP;
        { const int nb = r % 32, kb = r / 32;
            transpose_item(w_dn + (size_t)l * DFF * DM, DFF, DM, (bf16*)(ws_ + WS_WDN) + (size_t)l * DM * DFF, 64 * kb, 32 * nb, 32 * nb, scr, lane); }
    }
    for (int m = gw; m < TOK; m += NGW) rms_row_to_bf16(x + (size_t)m * DM, g0, (bf16*)(ws_ + WS_HB) + (size_t)m * DM, lane);
    float* rope = (float*)(ws_ + WS_ROPE);
    for (int e = gw * 64 + lane; e < SEQ * 8; e += NGW * 64) { const int s = e >> 3, i = e & 7;
        const float inv = i == 0 ? 1.0f : i == 1 ? 0.19392274f : i == 2 ? 0.03760603f : i == 3 ? 0.0072926646f : i == 4 ? 0.0014142136f : i == 5 ? 0.0002742482f : i == 6 ? 5.3182957e-05f : 1.0313385e-05f;
        const float ang = (float)s * inv;
        const float chi = 0.15915494f, clo = 6.4206382e-09f;
        const float hi = ang * chi; const float lo = __builtin_fmaf(ang, chi, -hi) + ang * clo;
        float fr_ = __builtin_amdgcn_fractf(hi) + lo;
        rope[s * 16 + i] = __builtin_amdgcn_cosf(fr_); rope[s * 16 + 8 + i] = __builtin_amdgcn_sinf(fr_); }
}

__device__ __forceinline__ void mixA_chunk(LAS unsigned char* lds, int chunk, const bf16* PROJ, const float* vg, const float* vb, const float* wsp, const float* bsp, const float* ga,
                                           bf16* MIXED, int tid, int wid, int lane) {
    LAS bf16* wsL = (LAS bf16*)lds;
    LAS bf16* vnT = (LAS bf16*)(lds + 34816);
    LAS float* stat = (LAS float*)(lds + 69632);
    const int t0 = chunk * 128, fr = lane & 15, fq = lane >> 4;
    WG_BARRIER();
    for (int i = 0; i < 16; ++i) { const int tk = 16 * wid + i;
        const u32x4 raw = *(const u32x4*)(PROJ + (size_t)(t0 + tk) * INC + 512 + 8 * lane);
        float x[8]; x[0] = bflo(raw.x); x[1] = bfhi(raw.x); x[2] = bflo(raw.y); x[3] = bfhi(raw.y); x[4] = bflo(raw.z); x[5] = bfhi(raw.z); x[6] = bflo(raw.w); x[7] = bfhi(raw.w);
        float s = 0.f;
#pragma unroll
        for (int e = 0; e < 8; ++e) s += x[e];
        const float mean = wave_sum(s, lane) * (1.0f / AW); float q = 0.f;
#pragma unroll
        for (int e = 0; e < 8; ++e) { const float d = x[e] - mean; q += d * d; }
        const float rstd = 1.0f / sqrtf(wave_sum(q, lane) * (1.0f / AW) + EPS);
        if (lane == 0) { stat[tk] = mean; stat[128 + tk] = rstd; }
    }
    float ssq = 0.f;
    const int p = 16 * wid + fr; const size_t t = (size_t)(t0 + p);
#pragma unroll 1
    for (int g = 0; g < 4; ++g) {
        WG_BARRIER();
#pragma unroll
        for (int it = 0; it < 8; ++it) { const int idx = (it * NTHR + tid) * 4; const int pp = idx >> 7, q = idx & 127;
            f32x4 w = *(const f32x4*)(wsp + g * 16384 + idx);
#pragma unroll
            for (int e = 0; e < 4; ++e) if (q + e > pp) w[e] = 0.f;
            u32x2 o; o.x = pk2(w[0], w[1]); o.y = pk2(w[2], w[3]); *(LAS u32x2*)(wsL + pp * 136 + q) = o; }
#pragma unroll
        for (int it = 0; it < 4; ++it) { const int id = it * NTHR + tid; const int q = id & 127, ck = id >> 7;
            const u32x4 raw = *(const u32x4*)(PROJ + (size_t)(t0 + q) * INC + 512 + g * 128 + 8 * ck);
            const float mean = stat[q], rstd = stat[128 + q];
            const f32x4 g0 = *(const f32x4*)(vg + g * 128 + 8 * ck), g1 = *(const f32x4*)(vg + g * 128 + 8 * ck + 4), b0 = *(const f32x4*)(vb + g * 128 + 8 * ck), b1 = *(const f32x4*)(vb + g * 128 + 8 * ck + 4);
            float x[8]; x[0] = bflo(raw.x); x[1] = bfhi(raw.x); x[2] = bflo(raw.y); x[3] = bfhi(raw.y); x[4] = bflo(raw.z); x[5] = bfhi(raw.z); x[6] = bflo(raw.w); x[7] = bfhi(raw.w);
#pragma unroll
            for (int e = 0; e < 8; ++e) { const float gg = e < 4 ? g0[e & 3] : g1[e & 3], bb = e < 4 ? b0[e & 3] : b1[e & 3];
                const float v = (x[e] - mean) * rstd * gg + bb; vnT[(8 * ck + e) * 136 + q] = (bf16)(pk2(v, 0.f) & 0xffffu); } }
        WG_BARRIER();
        f32x4 acc[8];
#pragma unroll
        for (int cb = 0; cb < 8; ++cb) acc[cb] = (f32x4){0.f, 0.f, 0.f, 0.f};
#pragma unroll
        for (int kk = 0; kk < 4; ++kk) {
            if (32 * kk <= 16 * wid + 15) {
                const bf16x8 y = *(const LAS bf16x8*)(wsL + (16 * wid + fr) * 136 + 32 * kk + 8 * fq);
#pragma unroll
                for (int cb = 0; cb < 8; ++cb) { const bf16x8 x = *(const LAS bf16x8*)(vnT + (16 * cb + fr) * 136 + 32 * kk + 8 * fq);
                    acc[cb] = __builtin_amdgcn_mfma_f32_16x16x32_bf16(x, y, acc[cb], 0, 0, 0); }
            }
        }
        const float bs = bsp[g * 128 + p];
#pragma unroll
        for (int cb = 0; cb < 8; ++cb) { const int ch = g * 128 + 16 * cb + 4 * fq;
            const u32x2 ur = *(const u32x2*)(PROJ + t * INC + ch);
            f32x4 u; u[0] = bflo(ur.x); u[1] = bfhi(ur.x); u[2] = bflo(ur.y); u[3] = bfhi(ur.y);
            const f32x4 o = u * (acc[cb] + bs); ssq += dot4(o);
            u32x2 w; w.x = pk2(o[0], o[1]); w.y = pk2(o[2], o[3]); *(u32x2*)(MIXED + t * DM + ch) = w; }
    }
    asm volatile("s_waitcnt vmcnt(0)" ::: "memory");
    ssq += pg8::shx(ssq, 16, lane); ssq += pg8::shx(ssq, 32, lane);
    const float rs = 1.0f / sqrtf(ssq * (1.0f / AW) + EPS);
#pragma unroll
    for (int g = 0; g < 4; ++g)
#pragma unroll
        for (int cb = 0; cb < 8; ++cb) { const int ch = g * 128 + 16 * cb + 4 * fq; const f32x4 gain = *(const f32x4*)(ga + ch);
            const u32x2 hr = *(const u32x2*)(MIXED + t * DM + ch);
            f32x4 o; o[0] = bflo(hr.x); o[1] = bfhi(hr.x); o[2] = bflo(hr.y); o[3] = bfhi(hr.y); o = o * rs * gain;
            u32x2 w; w.x = pk2(o[0], o[1]); w.y = pk2(o[2], o[3]); *(u32x2*)(MIXED + t * DM + ch) = w; }
}

__device__ __forceinline__ void attn_item(LAS unsigned char* lds, int item, const bf16* PROJ, bf16* OP, float* LSE, int tid, int wid, int lane) {
    LAS bf16* KL = (LAS bf16*)lds;
    LAS bf16* VT = (LAS bf16*)(lds + 36864);
    const int fr = lane & 15, fq = lane >> 4;
    const int bh = item / 96, w96 = item % 96; const int b = bh >> 3, h = bh & 7;
    const int pat = w96 >> 5, within = w96 & 31;
    const int dsh = 2 * pat, d = 1 << dsh, r = within & (d - 1), qb = within >> dsh;
    const size_t rowbase = (size_t)b * SEQ;
    WG_BARRIER();
#pragma unroll
    for (int it = 0; it < 4; ++it) { const int id = it * NTHR + tid; const int j = id >> 3, ck = id & 7;
        const int pos = ((qb - 1) * 128 + j) * d + r;
        u32x4 kv = {0u, 0u, 0u, 0u}, vv = kv;
        if (pos >= 0) { const bf16* rp = PROJ + (rowbase + (size_t)pos) * INC + h * 64 + 8 * ck; kv = *(const u32x4*)(rp + 1536); vv = *(const u32x4*)(rp + 2048); }
        *(LAS u32x4*)(KL + j * 72 + 8 * ck) = kv;
        LAS bf16* vp = VT + (8 * ck) * 264 + j;
        vp[0 * 264] = (bf16)(vv.x & 0xffffu); vp[1 * 264] = (bf16)(vv.x >> 16); vp[2 * 264] = (bf16)(vv.y & 0xffffu); vp[3 * 264] = (bf16)(vv.y >> 16);
        vp[4 * 264] = (bf16)(vv.z & 0xffffu); vp[5 * 264] = (bf16)(vv.z >> 16); vp[6 * 264] = (bf16)(vv.w & 0xffffu); vp[7 * 264] = (bf16)(vv.w >> 16); }
    const int qi = 16 * wid + fr; const int qpos = (qb * 128 + qi) * d + r; const size_t t = rowbase + (size_t)qpos;
    const bf16* qrow = PROJ + t * INC + 1024 + h * 64;
    const bf16x8 q0 = *(const bf16x8*)(qrow + 8 * fq), q1 = *(const bf16x8*)(qrow + 32 + 8 * fq);
    WG_BARRIER();
    f32x4 s[9];
#pragma unroll
    for (int kbi = 0; kbi < 9; ++kbi) { const int kb = wid + kbi;
        const bf16x8 x0 = *(const LAS bf16x8*)(KL + (16 * kb + fr) * 72 + 8 * fq), x1 = *(const LAS bf16x8*)(KL + (16 * kb + fr) * 72 + 32 + 8 * fq);
        f32x4 a = {0.f, 0.f, 0.f, 0.f};
        a = __builtin_amdgcn_mfma_f32_16x16x32_bf16(x0, q0, a, 0, 0, 0); a = __builtin_amdgcn_mfma_f32_16x16x32_bf16(x1, q1, a, 0, 0, 0); s[kbi] = a; }
    float mx = -3.0e38f;
#pragma unroll
    for (int kbi = 0; kbi < 9; ++kbi) {
        const bool blk_ok = (qb > 0) || (wid + kbi >= 8);
#pragma unroll
        for (int e = 0; e < 4; ++e) { const int c = 4 * fq + e;
            bool valid = blk_ok;
            if (kbi == 0) valid = valid && (c >= fr);
            if (kbi == 8) valid = valid && (c <= fr);
            const float v = valid ? s[kbi][e] : -1.0e30f; s[kbi][e] = v; mx = fmaxf(mx, v); }
    }
    mx = fmaxf(mx, pg8::shx(mx, 16, lane)); mx = fmaxf(mx, pg8::shx(mx, 32, lane));
    float l = 0.f; u32x2 pk[10];
#pragma unroll
    for (int kbi = 0; kbi < 9; ++kbi) { float pe[4];
#pragma unroll
        for (int e = 0; e < 4; ++e) { pe[e] = __builtin_amdgcn_exp2f((s[kbi][e] - mx) * 1.4426950408889634f); l += pe[e]; }
        pk[kbi].x = pk2(pe[0], pe[1]); pk[kbi].y = pk2(pe[2], pe[3]); }
    pk[9].x = 0u; pk[9].y = 0u;
    l += pg8::shx(l, 16, lane); l += pg8::shx(l, 32, lane);
    f32x4 oacc[4];
#pragma unroll
    for (int db = 0; db < 4; ++db) oacc[db] = (f32x4){0.f, 0.f, 0.f, 0.f};
#pragma unroll
    for (int pp = 0; pp < 5; ++pp) { const int kbA = wid + 2 * pp; int kbB = kbA + 1; kbB = kbB > 15 ? 15 : kbB;
        u32x4 yy; yy.x = pk[2 * pp].x; yy.y = pk[2 * pp].y; yy.z = pk[2 * pp + 1].x; yy.w = pk[2 * pp + 1].y;
        const bf16x8 yf = __builtin_bit_cast(bf16x8, yy);
#pragma unroll
        for (int db = 0; db < 4; ++db) { const u32x2 xa = *(const LAS u32x2*)(VT + (16 * db + fr) * 264 + 16 * kbA + 4 * fq), xb = *(const LAS u32x2*)(VT + (16 * db + fr) * 264 + 16 * kbB + 4 * fq);
            u32x4 xx; xx.x = xa.x; xx.y = xa.y; xx.z = xb.x; xx.w = xb.y;
            oacc[db] = __builtin_amdgcn_mfma_f32_16x16x32_bf16(__builtin_bit_cast(bf16x8, xx), yf, oacc[db], 0, 0, 0); } }
    const float inv = 1.0f / l;
    bf16* orow = OP + ((size_t)pat * TOK + t) * AW + h * 64 + 4 * fq;
#pragma unroll
    for (int db = 0; db < 4; ++db) { const f32x4 o = oacc[db] * inv; u32x2 w; w.x = pk2(o[0], o[1]); w.y = pk2(o[2], o[3]); *(u32x2*)(orow + 16 * db) = w; }
    if (fq == 0) LSE[((size_t)pat * TOK + t) * 8 + h] = mx + logf(l);
}

__device__ __forceinline__ void combine_rows(const bf16* OP, const float* LSE, const float* gb, bf16* MIXED, int gw, int NGW, int lane) {
    const f32x4 g0 = *(const f32x4*)(gb + 8 * lane), g1 = *(const f32x4*)(gb + 8 * lane + 4);
    for (int t = gw; t < TOK; t += NGW) {
        const int h = lane >> 3; float ls[3]; u32x4 raw[3];
#pragma unroll
        for (int p = 0; p < 3; ++p) { ls[p] = LSE[((size_t)p * TOK + t) * 8 + h]; raw[p] = *(const u32x4*)(OP + ((size_t)p * TOK + t) * AW + 8 * lane); }
        const float mx = fmaxf(ls[0], fmaxf(ls[1], ls[2]));
        float a[3]; float sum = 0.f;
#pragma unroll
        for (int p = 0; p < 3; ++p) { a[p] = __expf(ls[p] - mx); sum += a[p]; }
        const float inv = 1.0f / sum; float o[8];
#pragma unroll
        for (int e = 0; e < 8; ++e) o[e] = 0.f;
#pragma unroll
        for (int p = 0; p < 3; ++p) { const float w = a[p] * inv;
            o[0] += w * bflo(raw[p].x); o[1] += w * bfhi(raw[p].x); o[2] += w * bflo(raw[p].y); o[3] += w * bfhi(raw[p].y);
            o[4] += w * bflo(raw[p].z); o[5] += w * bfhi(raw[p].z); o[6] += w * bflo(raw[p].w); o[7] += w * bfhi(raw[p].w); }
        float ss = 0.f;
#pragma unroll
        for (int e = 0; e < 8; ++e) ss += o[e] * o[e];
        const float rs = 1.0f / sqrtf(wave_sum(ss, lane) * (1.0f / AW) + EPS);
        u32x4 w; w.x = pk2(o[0] * rs * g0[0], o[1] * rs * g0[1]); w.y = pk2(o[2] * rs * g0[2], o[3] * rs * g0[3]); w.z = pk2(o[4] * rs * g1[0], o[5] * rs * g1[1]); w.w = pk2(o[6] * rs * g1[2], o[7] * rs * g1[3]);
        *(u32x4*)(MIXED + (size_t)t * DM + 512 + 8 * lane) = w;
    }
}

__device__ __forceinline__ void residual_rows(const bf16* Y, const float* xin, float* xout, const float* g_post, const float* g_next, bf16* HB, int gw, int NGW, int lane) {
    for (int t = gw; t < TOK; t += NGW) {
        const u32x2* yr = (const u32x2*)(Y + (size_t)t * DM) + lane; const f32x4* xr = (const f32x4*)(xin + (size_t)t * DM) + lane;
        f32x4 yv[4], xv[4]; float s = 0.f;
#pragma unroll
        for (int j = 0; j < 4; ++j) { const u32x2 w = yr[64 * j]; xv[j] = xr[64 * j]; yv[j][0] = bflo(w.x); yv[j][1] = bfhi(w.x); yv[j][2] = bflo(w.y); yv[j][3] = bfhi(w.y); s += dot4(yv[j]); }
        const float ry = 1.0f / sqrtf(wave_sum(s, lane) * (1.0f / DM) + EPS); float s2 = 0.f;
        f32x4* xo = (f32x4*)(xout + (size_t)t * DM) + lane;
#pragma unroll
        for (int j = 0; j < 4; ++j) { const f32x4 gp = ((const f32x4*)g_post)[lane + 64 * j]; xv[j] = xv[j] + yv[j] * ry * gp; s2 += dot4(xv[j]); xo[64 * j] = xv[j]; }
        if (g_next) { const float rx = 1.0f / sqrtf(wave_sum(s2, lane) * (1.0f / DM) + EPS); u32x2* ho = (u32x2*)(HB + (size_t)t * DM) + lane;
#pragma unroll
            for (int j = 0; j < 4; ++j) { const f32x4 gn = ((const f32x4*)g_next)[lane + 64 * j]; const f32x4 hv = xv[j] * rx * gn; u32x2 w; w.x = pk2(hv[0], hv[1]); w.y = pk2(hv[2], hv[3]); ho[64 * j] = w; } }
    }
}

#define GAS __attribute__((address_space(1)))
#define XB_TMO      128
#define XB_XCNT(j)  (256  + 64 * (j))
#define XB_XSUB(j)  (1280 + 64 * (j))
#define XB_XGEN(j)  (2304 + 64 * (j))
#define XB_TOP      3328
#define XB_TOPGEN   3392
#define XCD_BAR_WORDS 3456
#define XB_SPIN_CAP (1u << 18)

__device__ __forceinline__ unsigned xb_ld(unsigned* p)              { return __hip_atomic_load(p, __ATOMIC_RELAXED, __HIP_MEMORY_SCOPE_AGENT); }
__device__ __forceinline__ unsigned xb_add(unsigned* p, unsigned v) { return __hip_atomic_fetch_add(p, v, __ATOMIC_RELAXED, __HIP_MEMORY_SCOPE_AGENT); }
__device__ __forceinline__ unsigned xb_xcc_id() { return (unsigned)__builtin_amdgcn_s_getreg((3 << 11) | 20) & 0xFu; }
#define XB_SPIN(cond, bar) do { unsigned _sp = 0; while (cond) { __builtin_amdgcn_s_sleep(1); \
    if ((++_sp & 255u) == 0u) { if (xb_ld(&(bar)[XB_TMO])) break; if (_sp > XB_SPIN_CAP) { atomicAdd(&(bar)[XB_TMO], 1u); break; } } } } while (0)

struct XcdBarrier {
    unsigned* bar; unsigned x;
    volatile LAS unsigned* st;
};

__device__ __forceinline__ XcdBarrier xcd_barrier_post(unsigned* bar, volatile LAS unsigned* st) {
    XcdBarrier b; b.bar = bar; b.x = xb_xcc_id(); b.st = st;
    if (threadIdx.x == 0) (void)xb_add(&bar[XB_XCNT(b.x)], 1u);
    return b;
}
__device__ __forceinline__ void xcd_barrier_complete(unsigned* bar, unsigned x, unsigned& nloc, unsigned& nx) {
    const unsigned G = gridDim.x * gridDim.y * gridDim.z;
    unsigned sum, cnt, mine, sp = 0u;
    for (;;) {
        sum = 0u; cnt = 0u; mine = 0u;
#pragma unroll
        for (unsigned j = 0; j < 16; ++j) { const unsigned c = xb_ld(&bar[XB_XCNT(j)]); sum += c; cnt += (c > 0u) ? 1u : 0u; mine = (j == x) ? c : mine; }
        if (sum == G) break;
        __builtin_amdgcn_s_sleep(1);
        if ((++sp & 255u) == 0u) { if (xb_ld(&bar[XB_TMO])) break; if (sp > XB_SPIN_CAP) { atomicAdd(&bar[XB_TMO], 1u); break; } }
    }
    nloc = mine > 0u ? mine : 1u; nx = cnt > 0u ? cnt : 1u;
}

__device__ __forceinline__ void xcd_barrier(const XcdBarrier& b) {
    asm volatile("s_waitcnt vmcnt(0)" ::: "memory");
    __syncthreads();
    if (threadIdx.x == 0) {
        unsigned* bar = b.bar;
        __builtin_amdgcn_s_waitcnt(0);
        unsigned nloc = b.st[0], nx = b.st[1];
        if (nloc == 0u) { xcd_barrier_complete(bar, b.x, nloc, nx); b.st[0] = nloc; b.st[1] = nx; }
        const unsigned old = xb_add(&bar[XB_XSUB(b.x)], 1u);
        const unsigned gen = old / nloc;
        if (old + 1u == (gen + 1u) * nloc) {
            __builtin_amdgcn_fence(__ATOMIC_RELEASE, "agent");
            asm volatile("s_waitcnt vmcnt(0)" ::: "memory");
            const unsigned og = xb_add(&bar[XB_TOP], 1u);
            const unsigned tg = og / nx;
            if (og + 1u == (tg + 1u) * nx) xb_add(&bar[XB_TOPGEN], 1u);
            else XB_SPIN(xb_ld(&bar[XB_TOPGEN]) == tg, bar);
            __builtin_amdgcn_fence(__ATOMIC_ACQUIRE, "agent");
            xb_add(&bar[XB_XGEN(b.x)], 1u);
            asm volatile("s_waitcnt vmcnt(0)" ::: "memory");
        } else {
            XB_SPIN(xb_ld(&bar[XB_XGEN(b.x)]) == gen, bar);
            __builtin_amdgcn_fence(__ATOMIC_ACQUIRE, "agent");
            asm volatile("s_waitcnt vmcnt(0)" ::: "memory");
        }
    }
    __syncthreads();
}

constexpr int N_PHASES = 1 + 8 * NLAYER;
__global__ void __launch_bounds__(NTHR) fwd_megakernel(Args args) {
    extern __shared__ __attribute__((aligned(16))) unsigned char lds_raw[];
    LAS unsigned char* lds = (LAS unsigned char*)lds_raw;
    cg::grid_group grid = cg::this_grid();
    const int lo = args.ph_lo, hi = args.ph_hi;
    if (threadIdx.x < 16) ((LAS unsigned*)(lds + MISC_OFF))[threadIdx.x] = 0u;
    __syncthreads();
    const XcdBarrier xbar = xcd_barrier_post((unsigned*)args.ws, (volatile LAS unsigned*)(lds + MISC_OFF));
    for (int ph = lo; ph < hi; ++ph) {
        int tid = threadIdx.x; asm volatile("" : "+v"(tid));
        int bx = blockIdx.x, G = gridDim.x; asm volatile("" : "+s"(bx), "+s"(G));
        const int lane = tid & 63, wave = __builtin_amdgcn_readfirstlane(tid >> 6);
        const int gw = bx * NWAVES + wave, NGW = G * NWAVES;
        const KAS unsigned char* kp = (const KAS unsigned char*)__builtin_amdgcn_kernarg_segment_ptr();
        asm volatile("" : "+s"(kp));
#define ARG_IN(i) (*(const float* const KAS*)(kp + 8 * (i)))
        float* const a_out = *(float* const KAS*)(kp + 136);
        unsigned char* const ws = *(unsigned char* const KAS*)(kp + 144);
        bf16* HB = (bf16*)(ws + WS_HB); bf16* PROJ = (bf16*)(ws + WS_PROJ); bf16* OPb = (bf16*)(ws + WS_OP); bf16* MIXED = (bf16*)(ws + WS_MIXED);
        bf16* Y1 = (bf16*)(ws + WS_Y1); bf16* Y2 = (bf16*)(ws + WS_Y2); bf16* HID = (bf16*)(ws + WS_HID); float* LSE = (float*)(ws + WS_LSE);
        const float* rope = (const float*)(ws + WS_ROPE);
        if (ph == 0) { for (int rep = 0; rep < ((PROBE_DBL & 16) ? 2 : 1); ++rep) prologue(ARG_IN(0), ARG_IN(1), ARG_IN(2), ARG_IN(9), ARG_IN(12), ARG_IN(15), ws, lds, gw, NGW, wave, lane); }
        else {
            const int l = (ph - 1) >> 3, k = (ph - 1) & 7;
            if (k == 0 || k == 3 || k == 5 || k == 6) {
                pg8::Gemm g; pg8::AnyOrder S; pg8::EpiAny E; E.bnd = (LAS float*)(lds + BND_OFF); E.a0 = nullptr; E.a1 = nullptr;
                S.mode = 0; S.uo.G = G; S.uo.c = bx;
                if (k == 0) {
                    g = pg8::Gemm{HB, (const bf16*)(ws + WS_WIN) + (size_t)l * INC * DM, TOK, INC, DM}; S.so.init(TOK, INC, G, bx); E.kind = 0; E.O = PROJ; E.a0 = rope;
                } else if (k == 3) {
                    g = pg8::Gemm{MIXED, (const bf16*)(ws + WS_WOUT) + (size_t)l * DM * DM, TOK, DM, DM}; S.so.init(TOK, DM, G, bx); E.kind = 1; E.O = Y1;
                } else if (k == 5) {
                    g = pg8::Gemm{HB, (const bf16*)(ws + WS_WUP) + (size_t)l * 2 * DFF * DM, TOK, 2 * DFF, DM}; S.so.init(TOK, 2 * DFF, G, bx); S.mode = 1; E.kind = 2; E.O = HID;
                    E.a0 = ARG_IN(13) + (size_t)l * 3 * 2 * DFF; E.a1 = ARG_IN(14) + (size_t)l * 2 * DFF;
                } else {
                    g = pg8::Gemm{HID, (const bf16*)(ws + WS_WDN) + (size_t)l * DM * DFF, TOK, DM, DFF}; S.so.init(TOK, DM, G, bx); E.kind = 1; E.O = Y2;
                }
                for (int rep = 0; rep < ((PROBE_DBL & 2) ? 2 : 1); ++rep) pg8::gemm_phase<pg8::EpiAny, pg8::AnyOrder, true, true>(lds, g, S, E, tid);
            } else if (k == 1) {
                for (int rep = 0; rep < ((PROBE_DBL & 4) ? 2 : 1); ++rep)
                for (int c = bx; c < TOK / 128; c += G)
                    mixA_chunk(lds, c, PROJ, ARG_IN(3) + l * AW, ARG_IN(4) + l * AW, ARG_IN(5) + (size_t)l * 4 * 128 * 128, ARG_IN(6) + l * 4 * 128, ARG_IN(7) + l * AW, MIXED, tid, wave, lane);
                constexpr int NITEM = BATCH * 8 * 96; const int per = (NITEM + G - 1) / G;
                for (int rep = 0; rep < ((PROBE_DBL & 1) ? 2 : 1); ++rep)
                for (int it = bx * per; it < (bx + 1) * per && it < NITEM; ++it) attn_item(lds, it, PROJ, OPb, LSE, tid, wave, lane);
            } else if (k == 2) {
                for (int rep = 0; rep < ((PROBE_DBL & 8) ? 2 : 1); ++rep) combine_rows(OPb, LSE, ARG_IN(8) + l * AW, MIXED, gw, NGW, lane);
            } else {
                const bool a = (k == 4);
                const float* xin = (a && l == 0) ? ARG_IN(0) : a_out;
                const float* gpost = (a ? ARG_IN(10) : ARG_IN(16)) + l * DM;
                const float* gnext = a ? ARG_IN(11) + l * DM : ((l + 1 < NLAYER) ? ARG_IN(1) + (l + 1) * DM : nullptr);
                if (PROBE_DBL & 64) residual_rows(a ? Y1 : Y2, xin, (float*)(ws + 192 * MiB), gpost, gnext, (bf16*)(ws + 320 * MiB), gw, NGW, lane);
                residual_rows(a ? Y1 : Y2, xin, a_out, gpost, gnext, HB, gw, NGW, lane);
            }
        }
        if (ph + 1 < hi) { if (ph == lo) grid.sync(); else xcd_barrier(xbar); if (PROBE_DBL & 32) xcd_barrier(xbar); }
    }
}

extern "C" void kernel_launch(void* const* d_in, const int* in_sizes, int n_in, void* d_out, int out_size, void* d_ws, size_t ws_size, hipStream_t stream) {
    static int grid = 0;
    if (grid == 0) {
        int dev = 0, cus = 0, per_cu = 0;
        if (n_in != 17 || out_size != TOK * DM || ws_size < WS_END) { fprintf(stderr, "kernel_launch: unexpected shapes (n_in %d, out %d, ws %zu)\n", n_in, out_size, ws_size); grid = -1; return; }
        hipGetDevice(&dev); hipDeviceGetAttribute(&cus, hipDeviceAttributeMultiprocessorCount, dev);
        if (hipFuncSetAttribute((const void*)fwd_megakernel, hipFuncAttributeMaxDynamicSharedMemorySize, LDS_BYTES) != hipSuccess) { fprintf(stderr, "kernel_launch: hipFuncSetAttribute failed\n"); grid = -1; return; }
        if (hipOccupancyMaxActiveBlocksPerMultiprocessor(&per_cu, (const void*)fwd_megakernel, NTHR, LDS_BYTES) != hipSuccess || per_cu < 1) { fprintf(stderr, "kernel_launch: occupancy query says %d\n", per_cu); per_cu = 1; }
        (void)hipGetLastError();
        grid = cus * per_cu;
        fprintf(stderr, "kernel_launch: grid %d (cus %d x %d)\n", grid, cus, per_cu);
    }
    if (grid < 0) return;
    if (hipMemsetAsync(d_ws, 0, 16384, stream) != hipSuccess) { fprintf(stderr, "kernel_launch: memset of the barrier words failed\n"); return; }
    Args a{};
    for (int i = 0; i < 17; ++i) a.in[i] = (const float*)d_in[i];
    a.out = (float*)d_out; a.ws = (unsigned char*)d_ws; a.ph_lo = 0; a.ph_hi = N_PHASES;
    void* kargs[] = {&a};
    hipError_t e = hipLaunchCooperativeKernel((const void*)fwd_megakernel, dim3(grid), dim3(NTHR), kargs, LDS_BYTES, stream);
    if (e != hipSuccess) fprintf(stderr, "kernel_launch: cooperative launch failed: %s (grid %d)\n", hipGetErrorString(e), grid);
}
```

```cpp
#include <hip/hip_runtime.h>
#include <hip/hip_cooperative_groups.h>
#include <cstdio>
#include <cstdint>
namespace cg = cooperative_groups;
#ifndef PROBE_DBL
#define PROBE_DBL 0
#endif
namespace pg8 {
#define PG8_LAS __attribute__((address_space(3)))
typedef unsigned short bf16_t;
typedef short bf16x8 __attribute__((ext_vector_type(8)));
typedef float f32x4 __attribute__((ext_vector_type(4)));
typedef unsigned u32x4 __attribute__((ext_vector_type(4)));
constexpr int BM = 256, BK = 64, HALF = 128, HTB = HALF * BK * 2  , STAGE_BYTES = 8 * HTB, NXCD = 8, WGM = 8;

__host__ __device__ __forceinline__ int lds_byte(int r, int c) { const int st = (r >> 4) * 2 + (c >> 5), rr = r & 15, cc = c & 31, ob = rr * 64 + cc * 2; return st * 1024 + (ob ^ (((ob >> 9) & 1) << 5)); }
__host__ __device__ __forceinline__ void stage_rc(int b, int& R, int& C) { const int st = b / 1024, sb = b % 1024, swz = sb ^ (((sb >> 9) & 1) << 5); R = (st >> 1) * 16 + swz / 64; C = (st & 1) * 32 + (swz % 64) / 2; }
__host__ __device__ __forceinline__ int perm32(int rho) { const int n = rho >> 4, i = rho & 15; return 8 * (i >> 2) + 4 * n + (i & 3); }

struct Unit { int pm, pn; };
struct Gemm { const bf16_t* A; const bf16_t* Bt; int M, N, K; };

struct StaticOrder {
    int nM, nN, nwg, G, c;
    __host__ __device__ void init(int M, int N, int G_, int c_) { nM = M / BM; nN = N / BM; nwg = nM * nN; G = G_; c = c_; }
    __host__ __device__ bool next(int i, Unit& u) const {
        const long L = (long)i * G + c; if (L >= nwg) return false;
        int wgid = (int)L; { const int q = nwg / NXCD, r = nwg % NXCD, xcd = wgid % NXCD, off = wgid / NXCD; wgid = (xcd < r ? xcd * (q + 1) : r * (q + 1) + (xcd - r) * q) + off; }
        const int nig = WGM * nN, gid = wgid / nig, fm = gid * WGM, gsz = (nM - fm) < WGM ? (nM - fm) : WGM;
        u.pm = fm + ((wgid % nig) % gsz); u.pn = (wgid % nig) / gsz; return true;
    }
    __device__ __forceinline__ void a_ready(const Unit&) const {}
    __device__ __forceinline__ void done(const Unit&) const {}
};

__device__ __forceinline__ unsigned cvt_pk_bf16(float lo, float hi) { unsigned r; asm volatile("v_cvt_pk_bf16_f32 %0, %1, %2" : "=v"(r) : "v"(lo), "v"(hi)); return r; }
typedef float f32x2 __attribute__((ext_vector_type(2)));
__device__ __forceinline__ f32x2 gelu_pk(f32x2 v) {
    const f32x2 av = __builtin_elementwise_abs(v), d = av * 0.2316418882f + 1.0f;
    f32x2 t; t.x = __builtin_amdgcn_rcpf(d.x); t.y = __builtin_amdgcn_rcpf(d.y);
    f32x2 q = t * 0.5307027145f + (-0.7265760135f); q = q * t + 0.7107068705f; q = q * t + (-0.142248368f); q = q * t + 0.127414796f; q = q * t;
    const f32x2 s = (v * v) * (-0.72134752044f);
    f32x2 e; e.x = __builtin_amdgcn_exp2f(s.x); e.y = __builtin_amdgcn_exp2f(s.y);
    const f32x2 m = v * (q * e), r = v - m;
    f32x2 o; o.x = v.x < 0.f ? m.x : r.x; o.y = v.y < 0.f ? m.y : r.y; return o;
}

template <int ACT  > struct EpiBf16 {
    static constexpr bool PERM = true, AFTER_DRAIN = false; static_assert(ACT == 0 || ACT == 1, "EpiBf16: ACT is 0 (none) or 1 (gelu_pk)");
    bf16_t* O; int ldc; const float* bias; int split_cols; size_t split_stride; float scale0;
    __device__ __forceinline__ void operator()(const f32x4 (&acc)[2][2][4][2], const Unit& u, int wr, int wc, int fr, int fq) const {
        const int row0 = u.pm * BM + wr * 64 + fr; int colt = u.pn * BM; bf16_t* base = O;
        float sc = 1.f; if (split_cols) { const int t = colt / split_cols; base += (size_t)t * split_stride; colt -= t * split_cols; if (t == 0) sc = scale0; }
        const int col0 = colt + wc * 32 + 8 * fq, bcol0 = u.pn * BM + wc * 32 + 8 * fq;
        f32x4 bv[2][2];
#pragma unroll
        for (int bj = 0; bj < 2; ++bj)
#pragma unroll
            for (int n = 0; n < 2; ++n) bv[bj][n] = bias ? *(const f32x4*)(bias + bcol0 + bj * HALF + 4 * n) : (f32x4){0.f, 0.f, 0.f, 0.f};
#pragma unroll
        for (int ai = 0; ai < 2; ++ai)
#pragma unroll
            for (int m = 0; m < 4; ++m) { bf16_t* rowp = base + (size_t)(row0 + ai * HALF + m * 16) * ldc + col0;
#pragma unroll
                for (int bj = 0; bj < 2; ++bj) { f32x4 v0 = acc[ai][bj][m][0] + bv[bj][0], v1 = acc[ai][bj][m][1] + bv[bj][1];
                    if (ACT == 1) { f32x2 a = gelu_pk((f32x2){v0[0], v0[1]}), b = gelu_pk((f32x2){v0[2], v0[3]}), c = gelu_pk((f32x2){v1[0], v1[1]}), d = gelu_pk((f32x2){v1[2], v1[3]});
                        v0 = (f32x4){a.x, a.y, b.x, b.y}; v1 = (f32x4){c.x, c.y, d.x, d.y}; }
                    v0 = v0 * sc; v1 = v1 * sc; u32x4 w; w.x = cvt_pk_bf16(v0[0], v0[1]); w.y = cvt_pk_bf16(v0[2], v0[3]); w.z = cvt_pk_bf16(v1[0], v1[1]); w.w = cvt_pk_bf16(v1[2], v1[3]);
                    *(u32x4*)(rowp + bj * HALF) = w; } }
    }
};

__device__ __forceinline__ float shx(float v, int m, int lane) { return __builtin_bit_cast(float, __builtin_amdgcn_ds_bpermute((lane ^ m) << 2, __builtin_bit_cast(int, v))); }
__device__ __forceinline__ float gelu_tanh_f(float x) {
    const float u = 0.7978845608028654f * (x + 0.044715f * x * x * x);
    const float e = __builtin_amdgcn_exp2f(-2.8853900817779268f * u);
    return x * __builtin_amdgcn_rcpf(1.0f + e);
}
struct EpiProj {
    static constexpr bool PERM = true, AFTER_DRAIN = false;
    bf16_t* O; const float* rope;
    __device__ __forceinline__ void operator()(const f32x4 (&acc)[2][2][4][2], const Unit& u, int wr, int wc, int fr, int fq) const {
        const int row0 = u.pm * BM + wr * 64 + fr; const int col0 = u.pn * BM + wc * 32 + 8 * fq;
        const int kind = u.pn < 4 ? 0 : (u.pn < 8 ? 1 : 2);
        const float qs = (u.pn < 6) ? 0.125f : 1.0f;
        const bool ropelane = ((wc & 1) == 0) && (fq < 2);
        const float sgn = (fq == 0) ? -1.0f : 1.0f;
#pragma unroll
        for (int ai = 0; ai < 2; ++ai)
#pragma unroll
            for (int m = 0; m < 4; ++m) {
                const int row = row0 + ai * HALF + m * 16;
                bf16_t* rowp = O + (size_t)row * 2560 + col0;
                f32x4 c0 = {1.f, 1.f, 1.f, 1.f}, c1 = c0, s0 = {0.f, 0.f, 0.f, 0.f}, s1 = s0;
                if (kind == 1 && ropelane) { const float* rp = rope + (size_t)(row & 4095) * 16;
                    c0 = *(const f32x4*)(rp); c1 = *(const f32x4*)(rp + 4); s0 = *(const f32x4*)(rp + 8); s1 = *(const f32x4*)(rp + 12); s0 = s0 * sgn; s1 = s1 * sgn; }
#pragma unroll
                for (int bj = 0; bj < 2; ++bj) {
                    f32x4 v0 = acc[ai][bj][m][0], v1 = acc[ai][bj][m][1];
                    if (kind == 0) {
                        f32x2 a = gelu_pk((f32x2){v0[0], v0[1]}), b = gelu_pk((f32x2){v0[2], v0[3]}), c = gelu_pk((f32x2){v1[0], v1[1]}), d = gelu_pk((f32x2){v1[2], v1[3]});
                        v0 = (f32x4){a.x, a.y, b.x, b.y}; v1 = (f32x4){c.x, c.y, d.x, d.y};
                    } else if (kind == 1) {
                        f32x4 p0, p1;
#pragma unroll
                        for (int e = 0; e < 4; ++e) { p0[e] = shx(v0[e], 16, fq * 16 + fr); p1[e] = shx(v1[e], 16, fq * 16 + fr); }
                        v0 = (v0 * c0 + p0 * s0) * qs; v1 = (v1 * c1 + p1 * s1) * qs;
                    }
                    u32x4 w; w.x = cvt_pk_bf16(v0[0], v0[1]); w.y = cvt_pk_bf16(v0[2], v0[3]); w.z = cvt_pk_bf16(v1[0], v1[1]); w.w = cvt_pk_bf16(v1[2], v1[3]);
                    *(u32x4*)(rowp + bj * HALF) = w;
                }
                asm volatile("" ::: "memory");
            }
    }
};
__device__ __forceinline__ float conv3_dpp(float cur, float prev, float w0, float w1, float w2, float b) {
    float r;
    asm volatile("s_nop 1\n\tv_fma_f32 %0, %3, %1, %6\n\t"
                 "v_fmac_f32_dpp %0, %1, %4 row_shr:1 row_mask:0xf bank_mask:0xf bound_ctrl:1\n\t"
                 "v_fmac_f32_dpp %0, %2, %4 row_shl:15 row_mask:0xf bank_mask:0xf bound_ctrl:1\n\t"
                 "v_fmac_f32_dpp %0, %1, %5 row_shr:2 row_mask:0xf bank_mask:0xf bound_ctrl:1\n\t"
                 "v_fmac_f32_dpp %0, %2, %5 row_shl:14 row_mask:0xf bank_mask:0xf bound_ctrl:1"
                 : "=&v"(r) : "v"(cur), "v"(prev), "v"(w2), "v"(w1), "v"(w0), "v"(b));
    return r;
}
template <int CTRL> __device__ __forceinline__ float dpp_z(float v) { return __builtin_bit_cast(float, __builtin_amdgcn_update_dpp(0, __builtin_bit_cast(int, v), CTRL, 0xf, 0xf, true)); }
__device__ __forceinline__ float dpp_ror1(float v) { return __builtin_bit_cast(float, __builtin_amdgcn_update_dpp(0, __builtin_bit_cast(int, v), 0x121, 0xf, 0xf, false)); }
__device__ __forceinline__ float dpp_ror2(float v) { return __builtin_bit_cast(float, __builtin_amdgcn_update_dpp(0, __builtin_bit_cast(int, v), 0x122, 0xf, 0xf, false)); }
struct EpiUp {
    static constexpr bool PERM = true, AFTER_DRAIN = false;
    bf16_t* H; const float* cw; const float* cb; PG8_LAS float* bnd;
    __device__ __forceinline__ void operator()(const f32x4 (&acc)[2][2][4][2], const Unit& u, int wr, int wc, int fr, int fq) const {
        const int par = u.pm & 1;
        PG8_LAS float* bw = bnd + par * 2048; PG8_LAS float* bo = bnd + (par ^ 1) * 2048;
        const int lc = wc * 32 + 8 * fq;
        if (fr >= 14) {
#pragma unroll
            for (int ai = 0; ai < 2; ++ai)
#pragma unroll
                for (int bj = 0; bj < 2; ++bj)
#pragma unroll
                    for (int n = 0; n < 2; ++n) *(PG8_LAS f32x4*)(bw + ((2 * ai + wr) * 2 + (fr - 14)) * 256 + bj * HALF + lc + 4 * n) = acc[ai][bj][3][n];
        }
        asm volatile("s_waitcnt lgkmcnt(0)" ::: "memory"); __builtin_amdgcn_s_barrier(); asm volatile("" ::: "memory");
        const bool first = (u.pm & 15) == 0;
        const int prow = fr >= 14 ? fr - 14 : 0;
        typedef float f32x2v __attribute__((ext_vector_type(2)));
#pragma unroll
        for (int n = 0; n < 2; ++n)
#pragma unroll
        for (int jp = 0; jp < 2; ++jp) {
            const int f0 = u.pn * HALF + lc + 4 * n + 2 * jp;
            const f32x2v wg0 = *(const f32x2v*)(cw + f0), wg1 = *(const f32x2v*)(cw + 8192 + f0), wg2 = *(const f32x2v*)(cw + 16384 + f0), bg = *(const f32x2v*)(cb + f0);
            const f32x2v wv0 = *(const f32x2v*)(cw + 4096 + f0), wv1 = *(const f32x2v*)(cw + 8192 + 4096 + f0), wv2 = *(const f32x2v*)(cw + 16384 + 4096 + f0), bv = *(const f32x2v*)(cb + 4096 + f0);
#pragma unroll
            for (int ai = 0; ai < 2; ++ai) {
                const int g = 2 * ai + wr;
                f32x2v pg = {0.f, 0.f}, pv = pg;
                if (g == 0) { if (!first) { pg = *(PG8_LAS f32x2v*)(bo + (3 * 2 + prow) * 256 + lc + 4 * n + 2 * jp); pv = *(PG8_LAS f32x2v*)(bo + (3 * 2 + prow) * 256 + HALF + lc + 4 * n + 2 * jp); } }
                else { pg = *(PG8_LAS f32x2v*)(bw + ((g - 1) * 2 + prow) * 256 + lc + 4 * n + 2 * jp); pv = *(PG8_LAS f32x2v*)(bw + ((g - 1) * 2 + prow) * 256 + HALF + lc + 4 * n + 2 * jp); }
#pragma unroll
                for (int m = 0; m < 4; ++m) {
                    float y[2];
#pragma unroll
                    for (int jj = 0; jj < 2; ++jj) {
                        const int j = 2 * jp + jj;
                        const float a = acc[ai][0][m][n][j], b = acc[ai][1][m][n][j];
                        const float qa = (m == 0) ? pg[jj] : acc[ai][0][m == 0 ? 0 : m - 1][n][j], qb = (m == 0) ? pv[jj] : acc[ai][1][m == 0 ? 0 : m - 1][n][j];
                        const float gcv = conv3_dpp(a, qa, wg0[jj], wg1[jj], wg2[jj], bg[jj]);
                        const float vcv = conv3_dpp(b, qb, wv0[jj], wv1[jj], wv2[jj], bv[jj]);
                        y[jj] = gelu_tanh_f(gcv) * vcv;
                    }
                    const int row = u.pm * BM + ai * HALF + wr * 64 + m * 16 + fr;
                    *(unsigned*)(H + (size_t)row * 4096 + f0) = cvt_pk_bf16(y[0], y[1]);
                }
            }
            asm volatile("" ::: "memory");
        }
    }
};
struct UpOrder {
    int G, c;
    __device__ bool next(int i, Unit& u) const {
        const int run = c + (i >> 4) * G; if (run >= 256) return false;
        const int xcd = run & 7, idx = run >> 3;
        u.pn = xcd * 4 + (idx & 3); u.pm = (idx >> 2) * 16 + (i & 15); return true;
    }
    __device__ __forceinline__ void a_ready(const Unit&) const {}
    __device__ __forceinline__ void done(const Unit&) const {}
};


struct EpiAny {
    static constexpr bool PERM = true, AFTER_DRAIN = false;
    int kind; bf16_t* O; const float* a0; const float* a1; PG8_LAS float* bnd;
    __device__ __forceinline__ void operator()(const f32x4 (&acc)[2][2][4][2], const Unit& u, int wr, int wc, int fr, int fq) const {
        if (kind == 0) { const EpiProj e{O, a0}; e(acc, u, wr, wc, fr, fq); }
        else if (kind == 1) { const EpiBf16<0> e{O, 1024, nullptr, 0, 0, 1.f}; e(acc, u, wr, wc, fr, fq); }
        else { const EpiUp e{O, a0, a1, bnd}; e(acc, u, wr, wc, fr, fq); }
    }
};
struct AnyOrder {
    int mode; StaticOrder so; UpOrder uo;
    __device__ __forceinline__ bool next(int i, Unit& u) const { return mode ? uo.next(i, u) : so.next(i, u); }
    __device__ __forceinline__ void a_ready(const Unit&) const {}
    __device__ __forceinline__ void done(const Unit&) const {}
};
template <class Epi, class Sched, bool ALIGN_EPI = false, bool SP2 = false>
__device__ __forceinline__ void gemm_phase(PG8_LAS unsigned char* lds, const Gemm g, const Sched& S, const Epi& E, const int tid) {
    const int wid = __builtin_amdgcn_readfirstlane(tid >> 6), lane = tid & 63, wr = wid >> 2, wc = wid & 3, fr = lane & 15, fq = lane >> 4;
    const int K = g.K, nt = K / BK;
    unsigned voffA[2], voffB[2];
#pragma unroll
    for (int i = 0; i < 2; ++i) { int R, C; stage_rc(tid * 16 + i * 8192, R, C); const int Rb = Epi::PERM ? ((R & ~31) + perm32(R & 31)) : R;
        voffA[i] = (unsigned)(R * K + C) * 2u; voffB[i] = (unsigned)(Rb * K + C) * 2u; }
    const size_t kstep = (size_t)(BK * 2);
    const size_t hstep = (size_t)HALF * K * 2;
    const size_t tstep = 2 * hstep;
    const unsigned ldsw = (unsigned)wid * 1024u;
    const int aoff = lds_byte(wr * 64 + fr, fq * 8), boff = lds_byte(wc * 32 + fr, fq * 8);
#define PG8_SA(b, h) (((b) * 2 + (h)) * HTB)
#define PG8_SB(b, h) ((4 + (b) * 2 + (h)) * HTB)
#define PG8_STAGE(bufoff, gbase, voff) do { _Pragma("unroll") for (int _i = 0; _i < 2; ++_i) \
        __builtin_amdgcn_global_load_lds((const unsigned*)((const char*)(gbase) + (voff)[_i]), (PG8_LAS unsigned*)(lds + (bufoff) + ldsw + _i * 8192), 16, 0, 0); } while (0)
#define PG8_LDA(dst, b, h) do { _Pragma("unroll") for (int m = 0; m < 4; ++m) _Pragma("unroll") for (int k = 0; k < 2; ++k) dst[m][k] = *(const PG8_LAS bf16x8*)(lds + PG8_SA(b, h) + aoff + m * 2048 + k * 1024); } while (0)
#define PG8_LDB(dst, b, h) do { _Pragma("unroll") for (int n = 0; n < 2; ++n) _Pragma("unroll") for (int k = 0; k < 2; ++k) dst[n][k] = *(const PG8_LAS bf16x8*)(lds + PG8_SB(b, h) + boff + n * 2048 + k * 1024); } while (0)
#define PG8_MMA(ai, bj, At, Bt) do { __builtin_amdgcn_s_setprio(1); _Pragma("unroll") for (int m = 0; m < 4; ++m) _Pragma("unroll") for (int n = 0; n < 2; ++n) _Pragma("unroll") for (int k = 0; k < 2; ++k) \
        acc[ai][bj][m][n] = __builtin_amdgcn_mfma_f32_16x16x32_bf16(Bt[n][k], At[m][k], acc[ai][bj][m][n], 0, 0, 0); __builtin_amdgcn_s_setprio(0); } while (0)
#define PG8_WAIT_V(n) asm volatile("s_waitcnt vmcnt(" #n ")" ::: "memory")
#define PG8_WAIT_L(n) asm volatile("s_waitcnt lgkmcnt(" #n ")" ::: "memory")
#define PG8_BAR __builtin_amdgcn_s_barrier()
#define PG8_SCHED __builtin_amdgcn_sched_barrier(0)
    Unit cur, nxt; int ui = 0;
    if (!S.next(0, cur)) return;
    f32x4 acc[2][2][4][2];
#pragma unroll
    for (int a = 0; a < 2; ++a)
#pragma unroll
        for (int b = 0; b < 2; ++b)
#pragma unroll
            for (int m = 0; m < 4; ++m)
#pragma unroll
                for (int n = 0; n < 2; ++n) acc[a][b][m][n] = (f32x4){0.f, 0.f, 0.f, 0.f};
    bf16x8 At[4][2], B0[2][2], B1[2][2];
    const char* cA = (const char*)g.A + (size_t)cur.pm * tstep; const char* cB = (const char*)g.Bt + (size_t)cur.pn * tstep;
    S.a_ready(cur);
    if constexpr (SP2) {
        PG8_STAGE(PG8_SB(0, 0), cB, voffB); PG8_STAGE(PG8_SB(0, 1), cB + hstep, voffB); PG8_STAGE(PG8_SA(0, 0), cA, voffA); PG8_STAGE(PG8_SA(0, 1), cA + hstep, voffA);
        if (wr == 1) PG8_BAR;
        PG8_WAIT_V(2); PG8_BAR;
        PG8_STAGE(PG8_SB(1, 0), cB + kstep, voffB); PG8_STAGE(PG8_SA(1, 0), cA + kstep, voffA); PG8_STAGE(PG8_SB(1, 1), cB + hstep + kstep, voffB);
        PG8_WAIT_V(6); PG8_BAR;
    } else {
        PG8_STAGE(PG8_SB(0, 0), cB, voffB); PG8_STAGE(PG8_SA(0, 0), cA, voffA); PG8_STAGE(PG8_SB(0, 1), cB + hstep, voffB); PG8_STAGE(PG8_SA(0, 1), cA + hstep, voffA);
        if (wr == 1) PG8_BAR;
        PG8_WAIT_V(4); PG8_BAR;
        PG8_STAGE(PG8_SB(1, 0), cB + kstep, voffB); PG8_STAGE(PG8_SA(1, 0), cA + kstep, voffA); PG8_STAGE(PG8_SB(1, 1), cB + hstep + kstep, voffB);
        PG8_WAIT_V(6); PG8_BAR;
    }
    for (;;) {
        const bool has_next = S.next(ui + 1, nxt);
        const char* nA = has_next ? (const char*)g.A + (size_t)nxt.pm * tstep : cA; const char* nB = has_next ? (const char*)g.Bt + (size_t)nxt.pn * tstep : cB;
        for (int t = 0; t < nt; t += 2) {
            const bool last = (t == nt - 2);
            const char* a1 = cA + (size_t)(t + 1) * kstep;
            const char* a2 = last ? nA : cA + (size_t)(t + 2) * kstep; const char* b2 = last ? nB : cB + (size_t)(t + 2) * kstep;
            const char* a3 = a2 + kstep; const char* b3 = b2 + kstep;
            if (last && has_next) S.a_ready(nxt);
            if constexpr (SP2) {
            PG8_LDB(B0, 0, 0); PG8_LDB(B1, 0, 1); PG8_SCHED; PG8_LDA(At, 0, 0); PG8_STAGE(PG8_SA(1, 1), a1 + hstep, voffA);
            PG8_WAIT_V(8); PG8_WAIT_L(0); PG8_BAR; PG8_MMA(0, 0, At, B0); PG8_MMA(0, 1, At, B1); PG8_BAR; PG8_SCHED;
            PG8_LDA(At, 0, 1); PG8_STAGE(PG8_SB(0, 0), b2, voffB); PG8_STAGE(PG8_SB(0, 1), b2 + hstep, voffB); PG8_STAGE(PG8_SA(0, 0), a2, voffA);
            PG8_WAIT_V(8); PG8_WAIT_L(0); PG8_BAR; PG8_MMA(1, 0, At, B0); PG8_MMA(1, 1, At, B1); PG8_BAR; PG8_SCHED;
            PG8_LDB(B0, 1, 0); PG8_LDB(B1, 1, 1); PG8_SCHED; PG8_LDA(At, 1, 0); PG8_STAGE(PG8_SA(0, 1), a2 + hstep, voffA);
            PG8_WAIT_V(8); PG8_WAIT_L(0); PG8_BAR; PG8_MMA(0, 0, At, B0); PG8_MMA(0, 1, At, B1); PG8_BAR; PG8_SCHED;
            PG8_LDA(At, 1, 1); PG8_STAGE(PG8_SB(1, 0), b3, voffB); PG8_STAGE(PG8_SB(1, 1), b3 + hstep, voffB); PG8_STAGE(PG8_SA(1, 0), a3, voffA);
            PG8_WAIT_V(8); PG8_WAIT_L(0); PG8_BAR; PG8_MMA(1, 0, At, B0); PG8_MMA(1, 1, At, B1); PG8_BAR; PG8_SCHED;
            } else {
            PG8_LDB(B0, 0, 0); PG8_SCHED; PG8_LDA(At, 0, 0); PG8_STAGE(PG8_SA(1, 1), a1 + hstep, voffA);
            PG8_WAIT_L(8); PG8_BAR; PG8_WAIT_L(0); PG8_MMA(0, 0, At, B0); PG8_BAR; PG8_SCHED;
            PG8_LDB(B1, 0, 1); PG8_STAGE(PG8_SB(0, 0), b2, voffB);
            PG8_BAR; PG8_WAIT_L(0); PG8_MMA(0, 1, At, B1); PG8_BAR;
            PG8_LDA(At, 0, 1); PG8_STAGE(PG8_SA(0, 0), a2, voffA);
            PG8_BAR; PG8_WAIT_L(0); PG8_MMA(1, 0, At, B0); PG8_BAR; PG8_SCHED;
            PG8_STAGE(PG8_SB(0, 1), b2 + hstep, voffB);
            PG8_WAIT_V(6); PG8_BAR; PG8_MMA(1, 1, At, B1); PG8_BAR;
            PG8_LDB(B0, 1, 0); PG8_SCHED; PG8_LDA(At, 1, 0); PG8_STAGE(PG8_SA(0, 1), a2 + hstep, voffA);
            PG8_WAIT_L(8); PG8_BAR; PG8_WAIT_L(0); PG8_MMA(0, 0, At, B0); PG8_BAR; PG8_SCHED;
            PG8_LDB(B1, 1, 1); PG8_STAGE(PG8_SB(1, 0), b3, voffB);
            PG8_BAR; PG8_WAIT_L(0); PG8_MMA(0, 1, At, B1); PG8_BAR;
            PG8_LDA(At, 1, 1); PG8_STAGE(PG8_SA(1, 0), a3, voffA);
            PG8_BAR; PG8_WAIT_L(0); PG8_MMA(1, 0, At, B0); PG8_BAR; PG8_SCHED;
            PG8_STAGE(PG8_SB(1, 1), b3 + hstep, voffB);
            PG8_WAIT_V(6); PG8_BAR; PG8_MMA(1, 1, At, B1); PG8_BAR;
            }
        }
        if constexpr (ALIGN_EPI) { if (wr == 0) PG8_BAR; }
        if constexpr (!Epi::AFTER_DRAIN) { E(acc, cur, wr, wc, fr, fq); S.done(cur); }
        if (!has_next) break;
#pragma unroll
        for (int a = 0; a < 2; ++a)
#pragma unroll
            for (int b = 0; b < 2; ++b)
#pragma unroll
                for (int m = 0; m < 4; ++m)
#pragma unroll
                    for (int n = 0; n < 2; ++n) acc[a][b][m][n] = (f32x4){0.f, 0.f, 0.f, 0.f};
        cur = nxt; cA = nA; cB = nB; ++ui;
        if constexpr (ALIGN_EPI) { if (wr == 1) PG8_BAR; }
    }
    PG8_WAIT_V(0);
    if constexpr (!ALIGN_EPI) { if (wr == 0) PG8_BAR; }
    PG8_BAR;
    if constexpr (Epi::AFTER_DRAIN) { E.fused(acc, cur, wr, wc, fr, fq, lds, wid, lane); S.done(cur); }
#undef PG8_SA
#undef PG8_SB
#undef PG8_STAGE
#undef PG8_LDA
#undef PG8_LDB
#undef PG8_MMA
#undef PG8_WAIT_V
#undef PG8_WAIT_L
#undef PG8_BAR
#undef PG8_SCHED
}
}

constexpr int NWAVES = 8, NTHR = NWAVES * 64;
constexpr int BATCH = 8, SEQ = 4096, DM = 1024, TOK = BATCH * SEQ, INC = 2560, AW = 512, DFF = 4096, NLAYER = 2;
constexpr float EPS = 1e-6f;
constexpr size_t MiB = 1u << 20;
constexpr size_t WS_WIN = 1 * MiB, WS_WOUT = 11 * MiB, WS_WUP = 15 * MiB, WS_WDN = 47 * MiB, WS_ROPE = 63 * MiB;
constexpr size_t WS_HB = 64 * MiB;
constexpr size_t WS_HID = 128 * MiB;
constexpr size_t WS_PROJ = 128 * MiB;
constexpr size_t WS_OP = 288 * MiB;
constexpr size_t WS_Y1 = 128 * MiB;
constexpr size_t WS_MIXED = 384 * MiB;
constexpr size_t WS_Y2 = 384 * MiB;
constexpr size_t WS_LSE = 448 * MiB;
constexpr size_t WS_END = 452 * MiB;
constexpr int LDS_BYTES = 147456 + 64;
constexpr int BND_OFF = 131072, MISC_OFF = 147456;

#define LAS __attribute__((address_space(3)))
#define KAS __attribute__((address_space(4)))
typedef unsigned short bf16;
typedef unsigned u32x4 __attribute__((ext_vector_type(4)));
typedef unsigned u32x2 __attribute__((ext_vector_type(2)));
typedef float f32x4 __attribute__((ext_vector_type(4)));
typedef short bf16x8 __attribute__((ext_vector_type(8)));
typedef short bf16x4 __attribute__((ext_vector_type(4)));

__device__ __forceinline__ float bflo(unsigned w) { return __builtin_bit_cast(float, w << 16); }
__device__ __forceinline__ float bfhi(unsigned w) { return __builtin_bit_cast(float, w & 0xffff0000u); }
__device__ __forceinline__ unsigned pk2(float lo, float hi) { return pg8::cvt_pk_bf16(lo, hi); }
__device__ __forceinline__ float wave_sum(float v, int lane) {
#pragma unroll
    for (int o = 1; o < 64; o <<= 1) v += pg8::shx(v, o, lane);
    return v;
}
__device__ __forceinline__ float dot4(f32x4 a) { return (a[0] * a[0] + a[1] * a[1]) + (a[2] * a[2] + a[3] * a[3]); }
#define WG_BARRIER() do { asm volatile("s_waitcnt vmcnt(0) lgkmcnt(0)" ::: "memory"); __builtin_amdgcn_s_barrier(); asm volatile("" ::: "memory"); } while (0)

__device__ __forceinline__ void transpose_item(const float* W, int K, int N, bf16* WT, int k0, int n0, int drow0, LAS float* scr, int lane) {
#pragma unroll 8
    for (int i = 0; i < 32; ++i) { const int kk = 2 * i + (lane >> 5); scr[kk * 33 + (lane & 31)] = W[(size_t)(k0 + kk) * N + n0 + (lane & 31)]; }
    asm volatile("s_waitcnt lgkmcnt(0)" ::: "memory");
    const int c = lane & 7;
#pragma unroll
    for (int j = 0; j < 4; ++j) { const int n = (lane >> 3) + 8 * j; const LAS float* s = scr + (8 * c) * 33 + n;
        u32x4 o; o.x = pk2(s[0 * 33], s[1 * 33]); o.y = pk2(s[2 * 33], s[3 * 33]); o.z = pk2(s[4 * 33], s[5 * 33]); o.w = pk2(s[6 * 33], s[7 * 33]);
        *(u32x4*)(WT + (size_t)(drow0 + n) * K + k0 + 8 * c) = o; }
    asm volatile("s_waitcnt lgkmcnt(0)" ::: "memory");
}
__device__ __forceinline__ void rms_row_to_bf16(const float* xrow, const float* g, bf16* orow, int lane) {
    const f32x4* xr = (const f32x4*)xrow + lane; const f32x4* gr = (const f32x4*)g + lane;
    f32x4 v[4]; float s = 0.f;
#pragma unroll
    for (int j = 0; j < 4; ++j) { v[j] = xr[64 * j]; s += dot4(v[j]); }
    const float rstd = 1.0f / sqrtf(wave_sum(s, lane) * (1.0f / DM) + EPS);
    u32x2* o8 = (u32x2*)orow + lane;
#pragma unroll
    for (int j = 0; j < 4; ++j) { const f32x4 gg = gr[64 * j]; const f32x4 y = v[j] * rstd * gg; u32x2 w; w.x = pk2(y[0], y[1]); w.y = pk2(y[2], y[3]); o8[64 * j] = w; }
}
struct Args { const float* in[17]; float* out; unsigned char* ws; int ph_lo, ph_hi; };
__device__ __forceinline__ void prologue(const float* x, const float* g0, const float* w_in, const float* w_out, const float* w_up, const float* w_dn, unsigned char* ws_, LAS unsigned char* lds, int gw, int NGW, int wave, int lane) {
    LAS float* scr = (LAS float*)(lds + wave * 16384);
    constexpr int I_IN = 16 * 80, I_OUT = 16 * 32, I_UP = 16 * 256, I_DN = 64 * 32, I_L = I_IN + I_OUT + I_UP + I_DN;
    for (int it = gw; it < NLAYER * I_L; it += NGW) {
        const int l = it / I_L; int r = it % I_L;
        if (r < I_IN) { const int nb = r % 80, kb = r / 80;
            transpose_item(w_in + (size_t)l * DM * INC, DM, INC, (bf16*)(ws_ + WS_WIN) + (size_t)l * INC * DM, 64 * kb, 32 * nb, 32 * nb, scr, lane); continue; }
        r -= I_IN;
        if (r < I_OUT) { const int nb = r % 32, kb = r / 32;
            transpose_item(w_out + (size_t)l * DM * DM, DM, DM, (bf16*)(ws_ + WS_WOUT) + (size_t)l * DM * DM, 64 * kb, 32 * nb, 32 * nb, scr, lane); continue; }
        r -= I_OUT;
        if (r < I_UP) { const int nb = r % 256, kb = r / 256; const int n0 = 32 * nb; const int f0 = n0 & 4095;
            const int drow0 = (f0 >> 7) * 256 + (n0 >= 4096 ? 128 : 0) + (f0 & 127);
            transpose_item(w_up + (size_t)l * DM * 2 * DFF, DM, 2 * DFF, (bf16*)(ws_ + WS_WUP) + (size_t)l * 2 * DFF * DM, 64 * kb, n0, drow0, scr, lane); continue; }
        r -= I_UP;
        { const int nb = r % 32, kb = r / 32;
            transpose_item(w_dn + (size_t)l * DFF * DM, DFF, DM, (bf16*)(ws_ + WS_WDN) + (size_t)l * DM * DFF, 64 * kb, 32 * nb, 32 * nb, scr, lane); }
    }
    for (int m = gw; m < TOK; m += NGW) rms_row_to_bf16(x + (size_t)m * DM, g0, (bf16*)(ws_ + WS_HB) + (size_t)m * DM, lane);
    float* rope = (float*)(ws_ + WS_ROPE);
    for (int e = gw * 64 + lane; e < SEQ * 8; e += NGW * 64) { const int s = e >> 3, i = e & 7;
        const float inv = i == 0 ? 1.0f : i == 1 ? 0.19392274f : i == 2 ? 0.03760603f : i == 3 ? 0.0072926646f : i == 4 ? 0.0014142136f : i == 5 ? 0.0002742482f : i == 6 ? 5.3182957e-05f : 1.0313385e-05f;
        const float ang = (float)s * inv;
        const float chi = 0.15915494f, clo = 6.4206382e-09f;
        const float hi = ang * chi; const float lo = __builtin_fmaf(ang, chi, -hi) + ang * clo;
        float fr_ = __builtin_amdgcn_fractf(hi) + lo;
        rope[s * 16 + i] = __builtin_amdgcn_cosf(fr_); rope[s * 16 + 8 + i] = __builtin_amdgcn_sinf(fr_); }
}

__device__ __forceinline__ void mixA_chunk(LAS unsigned char* lds, int chunk, const bf16* PROJ, const float* vg, const float* vb, const float* wsp, const float* bsp, const float* ga,
                                           bf16* MIXED, int tid, int wid, int lane) {
    LAS bf16* wsL = (LAS bf16*)lds;
    LAS bf16* vnT = (LAS bf16*)(lds + 34816);
    LAS float* stat = (LAS float*)(lds + 69632);
    const int t0 = chunk * 128, fr = lane & 15, fq = lane >> 4;
    WG_BARRIER();
    for (int i = 0; i < 16; ++i) { const int tk = 16 * wid + i;
        const u32x4 raw = *(const u32x4*)(PROJ + (size_t)(t0 + tk) * INC + 512 + 8 * lane);
        float x[8]; x[0] = bflo(raw.x); x[1] = bfhi(raw.x); x[2] = bflo(raw.y); x[3] = bfhi(raw.y); x[4] = bflo(raw.z); x[5] = bfhi(raw.z); x[6] = bflo(raw.w); x[7] = bfhi(raw.w);
        float s = 0.f;
#pragma unroll
        for (int e = 0; e < 8; ++e) s += x[e];
        const float mean = wave_sum(s, lane) * (1.0f / AW); float q = 0.f;
#pragma unroll
        for (int e = 0; e < 8; ++e) { const float d = x[e] - mean; q += d * d; }
        const float rstd = 1.0f / sqrtf(wave_sum(q, lane) * (1.0f / AW) + EPS);
        if (lane == 0) { stat[tk] = mean; stat[128 + tk] = rstd; }
    }
    float ssq = 0.f;
    const int p = 16 * wid + fr; const size_t t = (size_t)(t0 + p);
#pragma unroll 1
    for (int g = 0; g < 4; ++g) {
        WG_BARRIER();
#pragma unroll
        for (int it = 0; it < 8; ++it) { const int idx = (it * NTHR + tid) * 4; const int pp = idx >> 7, q = idx & 127;
            f32x4 w = *(const f32x4*)(wsp + g * 16384 + idx);
#pragma unroll
            for (int e = 0; e < 4; ++e) if (q + e > pp) w[e] = 0.f;
            u32x2 o; o.x = pk2(w[0], w[1]); o.y = pk2(w[2], w[3]); *(LAS u32x2*)(wsL + pp * 136 + q) = o; }
#pragma unroll
        for (int it = 0; it < 4; ++it) { const int id = it * NTHR + tid; const int q = id & 127, ck = id >> 7;
            const u32x4 raw = *(const u32x4*)(PROJ + (size_t)(t0 + q) * INC + 512 + g * 128 + 8 * ck);
            const float mean = stat[q], rstd = stat[128 + q];
            const f32x4 g0 = *(const f32x4*)(vg + g * 128 + 8 * ck), g1 = *(const f32x4*)(vg + g * 128 + 8 * ck + 4), b0 = *(const f32x4*)(vb + g * 128 + 8 * ck), b1 = *(const f32x4*)(vb + g * 128 + 8 * ck + 4);
            float x[8]; x[0] = bflo(raw.x); x[1] = bfhi(raw.x); x[2] = bflo(raw.y); x[3] = bfhi(raw.y); x[4] = bflo(raw.z); x[5] = bfhi(raw.z); x[6] = bflo(raw.w); x[7] = bfhi(raw.w);
#pragma unroll
            for (int e = 0; e < 8; ++e) { const float gg = e < 4 ? g0[e & 3] : g1[e & 3], bb = e < 4 ? b0[e & 3] : b1[e & 3];
                const float v = (x[e] - mean) * rstd * gg + bb; vnT[(8 * ck + e) * 136 + q] = (bf16)(pk2(v, 0.f) & 0xffffu); } }
        WG_BARRIER();
        f32x4 acc[8];
#pragma unroll
        for (int cb = 0; cb < 8; ++cb) acc[cb] = (f32x4){0.f, 0.f, 0.f, 0.f};
#pragma unroll
        for (int kk = 0; kk < 4; ++kk) {
            if (32 * kk <= 16 * wid + 15) {
                const bf16x8 y = *(const LAS bf16x8*)(wsL + (16 * wid + fr) * 136 + 32 * kk + 8 * fq);
#pragma unroll
                for (int cb = 0; cb < 8; ++cb) { const bf16x8 x = *(const LAS bf16x8*)(vnT + (16 * cb + fr) * 136 + 32 * kk + 8 * fq);
                    acc[cb] = __builtin_amdgcn_mfma_f32_16x16x32_bf16(x, y, acc[cb], 0, 0, 0); }
            }
        }
        const float bs = bsp[g * 128 + p];
#pragma unroll
        for (int cb = 0; cb < 8; ++cb) { const int ch = g * 128 + 16 * cb + 4 * fq;
            const u32x2 ur = *(const u32x2*)(PROJ + t * INC + ch);
            f32x4 u; u[0] = bflo(ur.x); u[1] = bfhi(ur.x); u[2] = bflo(ur.y); u[3] = bfhi(ur.y);
            const f32x4 o = u * (acc[cb] + bs); ssq += dot4(o);
            u32x2 w; w.x = pk2(o[0], o[1]); w.y = pk2(o[2], o[3]); *(u32x2*)(MIXED + t * DM + ch) = w; }
    }
    asm volatile("s_waitcnt vmcnt(0)" ::: "memory");
    ssq += pg8::shx(ssq, 16, lane); ssq += pg8::shx(ssq, 32, lane);
    const float rs = 1.0f / sqrtf(ssq * (1.0f / AW) + EPS);
#pragma unroll
    for (int g = 0; g < 4; ++g)
#pragma unroll
        for (int cb = 0; cb < 8; ++cb) { const int ch = g * 128 + 16 * cb + 4 * fq; const f32x4 gain = *(const f32x4*)(ga + ch);
            const u32x2 hr = *(const u32x2*)(MIXED + t * DM + ch);
            f32x4 o; o[0] = bflo(hr.x); o[1] = bfhi(hr.x); o[2] = bflo(hr.y); o[3] = bfhi(hr.y); o = o * rs * gain;
            u32x2 w; w.x = pk2(o[0], o[1]); w.y = pk2(o[2], o[3]); *(u32x2*)(MIXED + t * DM + ch) = w; }
}

__device__ __forceinline__ void attn_item(LAS unsigned char* lds, int item, const bf16* PROJ, bf16* OP, float* LSE, int tid, int wid, int lane) {
    LAS bf16* KL = (LAS bf16*)lds;
    LAS bf16* VT = (LAS bf16*)(lds + 36864);
    const int fr = lane & 15, fq = lane >> 4;
    const int bh = item / 96, w96 = item % 96; const int b = bh >> 3, h = bh & 7;
    const int pat = w96 >> 5, within = w96 & 31;
    const int dsh = 2 * pat, d = 1 << dsh, r = within & (d - 1), qb = within >> dsh;
    const size_t rowbase = (size_t)b * SEQ;
    WG_BARRIER();
#pragma unroll
    for (int it = 0; it < 4; ++it) { const int id = it * NTHR + tid; const int j = id >> 3, ck = id & 7;
        const int pos = ((qb - 1) * 128 + j) * d + r;
        u32x4 kv = {0u, 0u, 0u, 0u}, vv = kv;
        if (pos >= 0) { const bf16* rp = PROJ + (rowbase + (size_t)pos) * INC + h * 64 + 8 * ck; kv = *(const u32x4*)(rp + 1536); vv = *(const u32x4*)(rp + 2048); }
        *(LAS u32x4*)(KL + j * 72 + 8 * ck) = kv;
        LAS bf16* vp = VT + (8 * ck) * 264 + j;
        vp[0 * 264] = (bf16)(vv.x & 0xffffu); vp[1 * 264] = (bf16)(vv.x >> 16); vp[2 * 264] = (bf16)(vv.y & 0xffffu); vp[3 * 264] = (bf16)(vv.y >> 16);
        vp[4 * 264] = (bf16)(vv.z & 0xffffu); vp[5 * 264] = (bf16)(vv.z >> 16); vp[6 * 264] = (bf16)(vv.w & 0xffffu); vp[7 * 264] = (bf16)(vv.w >> 16); }
    const int qi = 16 * wid + fr; const int qpos = (qb * 128 + qi) * d + r; const size_t t = rowbase + (size_t)qpos;
    const bf16* qrow = PROJ + t * INC + 1024 + h * 64;
    const bf16x8 q0 = *(const bf16x8*)(qrow + 8 * fq), q1 = *(const bf16x8*)(qrow + 32 + 8 * fq);
    WG_BARRIER();
    f32x4 s[9];
#pragma unroll
    for (int kbi = 0; kbi < 9; ++kbi) { const int kb = wid + kbi;
        const bf16x8 x0 = *(const LAS bf16x8*)(KL + (16 * kb + fr) * 72 + 8 * fq), x1 = *(const LAS bf16x8*)(KL + (16 * kb + fr) * 72 + 32 + 8 * fq);
        f32x4 a = {0.f, 0.f, 0.f, 0.f};
        a = __builtin_amdgcn_mfma_f32_16x16x32_bf16(x0, q0, a, 0, 0, 0); a = __builtin_amdgcn_mfma_f32_16x16x32_bf16(x1, q1, a, 0, 0, 0); s[kbi] = a; }
    float mx = -3.0e38f;
#pragma unroll
    for (int kbi = 0; kbi < 9; ++kbi) {
        const bool blk_ok = (qb > 0) || (wid + kbi >= 8);
#pragma unroll
        for (int e = 0; e < 4; ++e) { const int c = 4 * fq + e;
            bool valid = blk_ok;
            if (kbi == 0) valid = valid && (c >= fr);
            if (kbi == 8) valid = valid && (c <= fr);
            const float v = valid ? s[kbi][e] : -1.0e30f; s[kbi][e] = v; mx = fmaxf(mx, v); }
    }
    mx = fmaxf(mx, pg8::shx(mx, 16, lane)); mx = fmaxf(mx, pg8::shx(mx, 32, lane));
    float l = 0.f; u32x2 pk[10];
#pragma unroll
    for (int kbi = 0; kbi < 9; ++kbi) { float pe[4];
#pragma unroll
        for (int e = 0; e < 4; ++e) { pe[e] = __builtin_amdgcn_exp2f((s[kbi][e] - mx) * 1.4426950408889634f); l += pe[e]; }
        pk[kbi].x = pk2(pe[0], pe[1]); pk[kbi].y = pk2(pe[2], pe[3]); }
    pk[9].x = 0u; pk[9].y = 0u;
    l += pg8::shx(l, 16, lane); l += pg8::shx(l, 32, lane);
    f32x4 oacc[4];
#pragma unroll
    for (int db = 0; db < 4; ++db) oacc[db] = (f32x4){0.f, 0.f, 0.f, 0.f};
#pragma unroll
    for (int pp = 0; pp < 5; ++pp) { const int kbA = wid + 2 * pp; int kbB = kbA + 1; kbB = kbB > 15 ? 15 : kbB;
        u32x4 yy; yy.x = pk[2 * pp].x; yy.y = pk[2 * pp].y; yy.z = pk[2 * pp + 1].x; yy.w = pk[2 * pp + 1].y;
        const bf16x8 yf = __builtin_bit_cast(bf16x8, yy);
#pragma unroll
        for (int db = 0; db < 4; ++db) { const u32x2 xa = *(const LAS u32x2*)(VT + (16 * db + fr) * 264 + 16 * kbA + 4 * fq), xb = *(const LAS u32x2*)(VT + (16 * db + fr) * 264 + 16 * kbB + 4 * fq);
            u32x4 xx; xx.x = xa.x; xx.y = xa.y; xx.z = xb.x; xx.w = xb.y;
            oacc[db] = __builtin_amdgcn_mfma_f32_16x16x32_bf16(__builtin_bit_cast(bf16x8, xx), yf, oacc[db], 0, 0, 0); } }
    const float inv = 1.0f / l;
    bf16* orow = OP + ((size_t)pat * TOK + t) * AW + h * 64 + 4 * fq;
#pragma unroll
    for (int db = 0; db < 4; ++db) { const f32x4 o = oacc[db] * inv; u32x2 w; w.x = pk2(o[0], o[1]); w.y = pk2(o[2], o[3]); *(u32x2*)(orow + 16 * db) = w; }
    if (fq == 0) LSE[((size_t)pat * TOK + t) * 8 + h] = mx + logf(l);
}

__device__ __forceinline__ void combine_rows(const bf16* OP, const float* LSE, const float* gb, bf16* MIXED, int gw, int NGW, int lane) {
    const f32x4 g0 = *(const f32x4*)(gb + 8 * lane), g1 = *(const f32x4*)(gb + 8 * lane + 4);
    for (int t = gw; t < TOK; t += NGW) {
        const int h = lane >> 3; float ls[3]; u32x4 raw[3];
#pragma unroll
        for (int p = 0; p < 3; ++p) { ls[p] = LSE[((size_t)p * TOK + t) * 8 + h]; raw[p] = *(const u32x4*)(OP + ((size_t)p * TOK + t) * AW + 8 * lane); }
        const float mx = fmaxf(ls[0], fmaxf(ls[1], ls[2]));
        float a[3]; float sum = 0.f;
#pragma unroll
        for (int p = 0; p < 3; ++p) { a[p] = __expf(ls[p] - mx); sum += a[p]; }
        const float inv = 1.0f / sum; float o[8];
#pragma unroll
        for (int e = 0; e < 8; ++e) o[e] = 0.f;
#pragma unroll
        for (int p = 0; p < 3; ++p) { const float w = a[p] * inv;
            o[0] += w * bflo(raw[p].x); o[1] += w * bfhi(raw[p].x); o[2] += w * bflo(raw[p].y); o[3] += w * bfhi(raw[p].y);
            o[4] += w * bflo(raw[p].z); o[5] += w * bfhi(raw[p].z); o[6] += w * bflo(raw[p].w); o[7] += w * bfhi(raw[p].w); }
        float ss = 0.f;
#pragma unroll
        for (int e = 0; e < 8; ++e) ss += o[e] * o[e];
        const float rs = 1.0f / sqrtf(wave_sum(ss, lane) * (1.0f / AW) + EPS);
        u32x4 w; w.x = pk2(o[0] * rs * g0[0], o[1] * rs * g0[1]); w.y = pk2(o[2] * rs * g0[2], o[3] * rs * g0[3]); w.z = pk2(o[4] * rs * g1[0], o[5] * rs * g1[1]); w.w = pk2(o[6] * rs * g1[2], o[7] * rs * g1[3]);
        *(u32x4*)(MIXED + (size_t)t * DM + 512 + 8 * lane) = w;
    }
}

__device__ __forceinline__ void residual_rows(const bf16* Y, const float* xin, float* xout, const float* g_post, const float* g_next, bf16* HB, int gw, int NGW, int lane) {
    for (int t = gw; t < TOK; t += NGW) {
        const u32x2* yr = (const u32x2*)(Y + (size_t)t * DM) + lane; const f32x4* xr = (const f32x4*)(xin + (size_t)t * DM) + lane;
        f32x4 yv[4], xv[4]; float s = 0.f;
#pragma unroll
        for (int j = 0; j < 4; ++j) { const u32x2 w = yr[64 * j]; xv[j] = xr[64 * j]; yv[j][0] = bflo(w.x); yv[j][1] = bfhi(w.x); yv[j][2] = bflo(w.y); yv[j][3] = bfhi(w.y); s += dot4(yv[j]); }
        const float ry = 1.0f / sqrtf(wave_sum(s, lane) * (1.0f / DM) + EPS); float s2 = 0.f;
        f32x4* xo = (f32x4*)(xout + (size_t)t * DM) + lane;
#pragma unroll
        for (int j = 0; j < 4; ++j) { const f32x4 gp = ((const f32x4*)g_post)[lane + 64 * j]; xv[j] = xv[j] + yv[j] * ry * gp; s2 += dot4(xv[j]); xo[64 * j] = xv[j]; }
        if (g_next) { const float rx = 1.0f / sqrtf(wave_sum(s2, lane) * (1.0f / DM) + EPS); u32x2* ho = (u32x2*)(HB + (size_t)t * DM) + lane;
#pragma unroll
            for (int j = 0; j < 4; ++j) { const f32x4 gn = ((const f32x4*)g_next)[lane + 64 * j]; const f32x4 hv = xv[j] * rx * gn; u32x2 w; w.x = pk2(hv[0], hv[1]); w.y = pk2(hv[2], hv[3]); ho[64 * j] = w; } }
    }
}

#define GAS __attribute__((address_space(1)))
#define XB_TMO      128
#define XB_XCNT(j)  (256  + 64 * (j))
#define XB_XSUB(j)  (1280 + 64 * (j))
#define XB_XGEN(j)  (2304 + 64 * (j))
#define XB_TOP      3328
#define XB_TOPGEN   3392
#define XCD_BAR_WORDS 3456
#define XB_SPIN_CAP (1u << 18)

__device__ __forceinline__ unsigned xb_ld(unsigned* p)              { return __hip_atomic_load(p, __ATOMIC_RELAXED, __HIP_MEMORY_SCOPE_AGENT); }
__device__ __forceinline__ unsigned xb_add(unsigned* p, unsigned v) { return __hip_atomic_fetch_add(p, v, __ATOMIC_RELAXED, __HIP_MEMORY_SCOPE_AGENT); }
__device__ __forceinline__ unsigned xb_xcc_id() { return (unsigned)__builtin_amdgcn_s_getreg((3 << 11) | 20) & 0xFu; }
#define XB_SPIN(cond, bar) do { unsigned _sp = 0; while (cond) { __builtin_amdgcn_s_sleep(1); \
    if ((++_sp & 255u) == 0u) { if (xb_ld(&(bar)[XB_TMO])) break; if (_sp > XB_SPIN_CAP) { atomicAdd(&(bar)[XB_TMO], 1u); break; } } } } while (0)

struct XcdBarrier {
    unsigned* bar; unsigned x;
    volatile LAS unsigned* st;
};

__device__ __forceinline__ XcdBarrier xcd_barrier_post(unsigned* bar, volatile LAS unsigned* st) {
    XcdBarrier b; b.bar = bar; b.x = xb_xcc_id(); b.st = st;
    if (threadIdx.x == 0) (void)xb_add(&bar[XB_XCNT(b.x)], 1u);
    return b;
}
__device__ __forceinline__ void xcd_barrier_complete(unsigned* bar, unsigned x, unsigned& nloc, unsigned& nx) {
    const unsigned G = gridDim.x * gridDim.y * gridDim.z;
    unsigned sum, cnt, mine, sp = 0u;
    for (;;) {
        sum = 0u; cnt = 0u; mine = 0u;
#pragma unroll
        for (unsigned j = 0; j < 16; ++j) { const unsigned c = xb_ld(&bar[XB_XCNT(j)]); sum += c; cnt += (c > 0u) ? 1u : 0u; mine = (j == x) ? c : mine; }
        if (sum == G) break;
        __builtin_amdgcn_s_sleep(1);
        if ((++sp & 255u) == 0u) { if (xb_ld(&bar[XB_TMO])) break; if (sp > XB_SPIN_CAP) { atomicAdd(&bar[XB_TMO], 1u); break; } }
    }
    nloc = mine > 0u ? mine : 1u; nx = cnt > 0u ? cnt : 1u;
}

__device__ __forceinline__ void xcd_barrier(const XcdBarrier& b) {
    asm volatile("s_waitcnt vmcnt(0)" ::: "memory");
    __syncthreads();
    if (threadIdx.x == 0) {
        unsigned* bar = b.bar;
        __builtin_amdgcn_s_waitcnt(0);
        unsigned nloc = b.st[0], nx = b.st[1];
        if (nloc == 0u) { xcd_barrier_complete(bar, b.x, nloc, nx); b.st[0] = nloc; b.st[1] = nx; }
        const unsigned old = xb_add(&bar[XB_XSUB(b.x)], 1u);
        const unsigned gen = old / nloc;
        if (old + 1u == (gen + 1u) * nloc) {
            __builtin_amdgcn_fence(__ATOMIC_RELEASE, "agent");
            asm volatile("s_waitcnt vmcnt(0)" ::: "memory");
            const unsigned og = xb_add(&bar[XB_TOP], 1u);
            const unsigned tg = og / nx;
            if (og + 1u == (tg + 1u) * nx) xb_add(&bar[XB_TOPGEN], 1u);
            else XB_SPIN(xb_ld(&bar[XB_TOPGEN]) == tg, bar);
            __builtin_amdgcn_fence(__ATOMIC_ACQUIRE, "agent");
            xb_add(&bar[XB_XGEN(b.x)], 1u);
            asm volatile("s_waitcnt vmcnt(0)" ::: "memory");
        } else {
            XB_SPIN(xb_ld(&bar[XB_XGEN(b.x)]) == gen, bar);
            __builtin_amdgcn_fence(__ATOMIC_ACQUIRE, "agent");
            asm volatile("s_waitcnt vmcnt(0)" ::: "memory");
        }
    }
    __syncthreads();
}

constexpr int N_PHASES = 1 + 8 * NLAYER;
__global__ void __launch_bounds__(NTHR) fwd_megakernel(Args args) {
    extern __shared__ __attribute__((aligned(16))) unsigned char lds_raw[];
    LAS unsigned char* lds = (LAS unsigned char*)lds_raw;
    cg::grid_group grid = cg::this_grid();
    const int lo = args.ph_lo, hi = args.ph_hi;
    if (threadIdx.x < 16) ((LAS unsigned*)(lds + MISC_OFF))[threadIdx.x] = 0u;
    __syncthreads();
    const XcdBarrier xbar = xcd_barrier_post((unsigned*)args.ws, (volatile LAS unsigned*)(lds + MISC_OFF));
    for (int ph = lo; ph < hi; ++ph) {
        int tid = threadIdx.x; asm volatile("" : "+v"(tid));
        int bx = blockIdx.x, G = gridDim.x; asm volatile("" : "+s"(bx), "+s"(G));
        const int lane = tid & 63, wave = __builtin_amdgcn_readfirstlane(tid >> 6);
        const int gw = bx * NWAVES + wave, NGW = G * NWAVES;
        const KAS unsigned char* kp = (const KAS unsigned char*)__builtin_amdgcn_kernarg_segment_ptr();
        asm volatile("" : "+s"(kp));
#define ARG_IN(i) (*(const float* const KAS*)(kp + 8 * (i)))
        float* const a_out = *(float* const KAS*)(kp + 136);
        unsigned char* const ws = *(unsigned char* const KAS*)(kp + 144);
        bf16* HB = (bf16*)(ws + WS_HB); bf16* PROJ = (bf16*)(ws + WS_PROJ); bf16* OPb = (bf16*)(ws + WS_OP); bf16* MIXED = (bf16*)(ws + WS_MIXED);
        bf16* Y1 = (bf16*)(ws + WS_Y1); bf16* Y2 = (bf16*)(ws + WS_Y2); bf16* HID = (bf16*)(ws + WS_HID); float* LSE = (float*)(ws + WS_LSE);
        const float* rope = (const float*)(ws + WS_ROPE);
        if (ph == 0) { for (int rep = 0; rep < ((PROBE_DBL & 16) ? 2 : 1); ++rep) prologue(ARG_IN(0), ARG_IN(1), ARG_IN(2), ARG_IN(9), ARG_IN(12), ARG_IN(15), ws, lds, gw, NGW, wave, lane); }
        else {
            const int l = (ph - 1) >> 3, k = (ph - 1) & 7;
            if (k == 0 || k == 3 || k == 5 || k == 6) {
                pg8::Gemm g; pg8::AnyOrder S; pg8::EpiAny E; E.bnd = (LAS float*)(lds + BND_OFF); E.a0 = nullptr; E.a1 = nullptr;
                S.mode = 0; S.uo.G = G; S.uo.c = bx;
                if (k == 0) {
                    g = pg8::Gemm{HB, (const bf16*)(ws + WS_WIN) + (size_t)l * INC * DM, TOK, INC, DM}; S.so.init(TOK, INC, G, bx); E.kind = 0; E.O = PROJ; E.a0 = rope;
                } else if (k == 3) {
                    g = pg8::Gemm{MIXED, (const bf16*)(ws + WS_WOUT) + (size_t)l * DM * DM, TOK, DM, DM}; S.so.init(TOK, DM, G, bx); E.kind = 1; E.O = Y1;
                } else if (k == 5) {
                    g = pg8::Gemm{HB, (const bf16*)(ws + WS_WUP) + (size_t)l * 2 * DFF * DM, TOK, 2 * DFF, DM}; S.so.init(TOK, 2 * DFF, G, bx); S.mode = 1; E.kind = 2; E.O = HID;
                    E.a0 = ARG_IN(13) + (size_t)l * 3 * 2 * DFF; E.a1 = ARG_IN(14) + (size_t)l * 2 * DFF;
                } else {
                    g = pg8::Gemm{HID, (const bf16*)(ws + WS_WDN) + (size_t)l * DM * DFF, TOK, DM, DFF}; S.so.init(TOK, DM, G, bx); E.kind = 1; E.O = Y2;
                }
                for (int rep = 0; rep < ((PROBE_DBL & 2) ? 2 : 1); ++rep) pg8::gemm_phase<pg8::EpiAny, pg8::AnyOrder, true, true>(lds, g, S, E, tid);
            } else if (k == 1) {
                for (int rep = 0; rep < ((PROBE_DBL & 4) ? 2 : 1); ++rep)
                for (int c = bx; c < TOK / 128; c += G)
                    mixA_chunk(lds, c, PROJ, ARG_IN(3) + l * AW, ARG_IN(4) + l * AW, ARG_IN(5) + (size_t)l * 4 * 128 * 128, ARG_IN(6) + l * 4 * 128, ARG_IN(7) + l * AW, MIXED, tid, wave, lane);
                constexpr int NITEM = BATCH * 8 * 96; const int per = (NITEM + G - 1) / G;
                for (int rep = 0; rep < ((PROBE_DBL & 1) ? 2 : 1); ++rep)
                for (int it = bx * per; it < (bx + 1) * per && it < NITEM; ++it) attn_item(lds, it, PROJ, OPb, LSE, tid, wave, lane);
            } else if (k == 2) {
                for (int rep = 0; rep < ((PROBE_DBL & 8) ? 2 : 1); ++rep) combine_rows(OPb, LSE, ARG_IN(8) + l * AW, MIXED, gw, NGW, lane);
            } else {
                const bool a = (k == 4);
                const float* xin = (a && l == 0) ? ARG_IN(0) : a_out;
                const float* gpost = (a ? ARG_IN(10) : ARG_IN(16)) + l * DM;
                const float* gnext = a ? ARG_IN(11) + l * DM : ((l + 1 < NLAYER) ? ARG_IN(1) + (l + 1) * DM : nullptr);
                if (PROBE_DBL & 64) residual_rows(a ? Y1 : Y2, xin, (float*)(ws + 192 * MiB), gpost, gnext, (bf16*)(ws + 320 * MiB), gw, NGW, lane);
                residual_rows(a ? Y1 : Y2, xin, a_out, gpost, gnext, HB, gw, NGW, lane);
            }
        }
        if (ph + 1 < hi) { if (ph == lo) grid.sync(); else xcd_barrier(xbar); if (PROBE_DBL & 32) xcd_barrier(xbar); }
    }
}

extern "C" void kernel_launch(void* const* d_in, const int* in_sizes, int n_in, void* d_out, int out_size, void* d_ws, size_t ws_size, hipStream_t stream) {
    static int grid = 0;
    if (grid == 0) {
        int dev = 0, cus = 0, per_cu = 0;
        if (n_in != 17 || out_size != TOK * DM || ws_size < WS_END) { fprintf(stderr, "kernel_launch: unexpected shapes (n_in %d, out %d, ws %zu)\n", n_in, out_size, ws_size); grid = -1; return; }
        hipGetDevice(&dev); hipDeviceGetAttribute(&cus, hipDeviceAttributeMultiprocessorCount, dev);
        if (hipFuncSetAttribute((const void*)fwd_megakernel, hipFuncAttributeMaxDynamicSharedMemorySize, LDS_BYTES) != hipSuccess) { fprintf(stderr, "kernel_launch: hipFuncSetAttribute failed\n"); grid = -1; return; }
        if (hipOccupancyMaxActiveBlocksPerMultiprocessor(&per_cu, (const void*)fwd_megakernel, NTHR, LDS_BYTES) != hipSuccess || per_cu < 1) { fprintf(stderr, "kernel_launch: occupancy query says %d\n", per_cu); per_cu = 1; }
        (void)hipGetLastError();
        grid = cus * per_cu;
        fprintf(stderr, "kernel_launch: grid %d (cus %d x %d)\n", grid, cus, per_cu);
    }
    if (grid < 0) return;
    if (hipMemsetAsync(d_ws, 0, 16384, stream) != hipSuccess) { fprintf(stderr, "kernel_launch: memset of the barrier words failed\n"); return; }
    Args a{};
    for (int i = 0; i < 17; ++i) a.in[i] = (const float*)d_in[i];
    a.out = (float*)d_out; a.ws = (unsigned char*)d_ws; a.ph_lo = 0; a.ph_hi = N_PHASES;
    void* kargs[] = {&a};
    hipError_t e = hipLaunchCooperativeKernel((const void*)fwd_megakernel, dim3(grid), dim3(NTHR), kargs, LDS_BYTES, stream);
    if (e != hipSuccess) fprintf(stderr, "kernel_launch: cooperative launch failed: %s (grid %d)\n", hipGetErrorString(e), grid);
}
```
